# Optimizing an MI355X kernel written in HIP

```python
import math
import jax, jax.numpy as jnp
from jax import lax
import numpy as np

D_MODEL = 1024
BATCH = 8
SEQ = 2048
DEPTH = 4

MIX_WIDTH = D_MODEL
POOL_WIDTH = MIX_WIDTH // 2
POOL_WINDOWS = (2, 4, 8, 16)
POOL_GROUPS = len(POOL_WINDOWS)
POOL_GC = POOL_WIDTH // POOL_GROUPS
N_HEADS = 4
QK_NOPE = 128
QK_ROPE = 64
V_HEAD = 128
QK_HEAD = QK_NOPE + QK_ROPE
MLA_WIDTH = N_HEADS * V_HEAD
Q_LORA = 384
KV_LORA = 256
ROPE_THETA = 10000.0
SOFTMAX_SCALE = 1.0 / math.sqrt(QK_HEAD)
Q_BLOCK = 128
IN_COLS = POOL_WIDTH + Q_LORA + KV_LORA + QK_ROPE
D_FF = 2816
N_SUBLAYERS = 3
EPS = 1e-6

kernel_name = "hybrid_macaron_pool_mla_adaln"


def rms_norm(x, g):
    xf = x.astype(jnp.float32)
    y = xf * lax.rsqrt(jnp.mean(xf * xf, axis=-1, keepdims=True) + EPS)
    return (y * g.astype(jnp.float32)).astype(x.dtype)


def modulate(h, shift, scale):
    return h * (1 + scale[:, None, :]) + shift[:, None, :]


def swiglu(h, w_gate, w_up, w_down):
    return (jax.nn.silu(h @ w_gate) * (h @ w_up)) @ w_down


def rotate_half(x):
    x1, x2 = jnp.split(x, 2, axis=-1)
    return jnp.concatenate([-x2, x1], axis=-1)


def apply_rope(x, cos, sin):
    return x * cos + rotate_half(x) * sin


def causal_multiscale_pool(u, pool_w, pool_scale):
    B, S, C = u.shape
    cs = jnp.cumsum(u.astype(jnp.float32), axis=1)
    pos = jnp.arange(S)
    means = []
    for g, w in enumerate(POOL_WINDOWS):
        csg = cs[..., g * POOL_GC:(g + 1) * POOL_GC]
        lag = jnp.pad(csg, ((0, 0), (w, 0), (0, 0)))[:, :S]
        cnt = jnp.minimum(pos + 1, w).astype(jnp.float32)[None, :, None]
        means.append((csg - lag) / cnt)
    pooled = jnp.stack(means, axis=2).astype(u.dtype)
    diff = pooled - u.reshape(B, S, POOL_GROUPS, POOL_GC)
    y = jnp.einsum('bsgc,gcd->bsgd', diff, pool_w).reshape(B, S, C)
    return y * pool_scale


def mla_attention(cq, ckv, kr, q_a_norm, w_q_b, kv_a_norm, w_kv_b, cos, sin):
    B, S, _ = cq.shape
    q = (rms_norm(cq, q_a_norm) @ w_q_b).reshape(B, S, N_HEADS, QK_HEAD)
    q_nope, q_rope = q[..., :QK_NOPE], q[..., QK_NOPE:]
    q_rope = apply_rope(q_rope, cos[:, :, None, :], sin[:, :, None, :])
    kv = (rms_norm(ckv, kv_a_norm) @ w_kv_b).reshape(B, S, N_HEADS, QK_NOPE + V_HEAD)
    k_nope, v = kv[..., :QK_NOPE], kv[..., QK_NOPE:]
    k_rope = apply_rope(kr, cos, sin)

    nb = S // Q_BLOCK
    qn = q_nope.reshape(B, nb, Q_BLOCK, N_HEADS, QK_NOPE).transpose(1, 0, 3, 2, 4)
    qr = q_rope.reshape(B, nb, Q_BLOCK, N_HEADS, QK_ROPE).transpose(1, 0, 3, 2, 4)
    kn = k_nope.transpose(0, 2, 1, 3)
    vv = v.transpose(0, 2, 1, 3)
    kpos = jnp.arange(S)

    def block(args):
        qn_b, qr_b, i = args
        s = (jnp.einsum('bhqd,bhkd->bhqk', qn_b, kn)
             + jnp.einsum('bhqd,bkd->bhqk', qr_b, k_rope)).astype(jnp.float32) * SOFTMAX_SCALE
        qpos = i * Q_BLOCK + jnp.arange(Q_BLOCK)
        s = jnp.where(qpos[:, None] >= kpos[None, :], s, -jnp.inf)
        p = jax.nn.softmax(s, axis=-1).astype(vv.dtype)
        return jnp.einsum('bhqk,bhkd->bhqd', p, vv)

    o = lax.map(block, (qn, qr, jnp.arange(nb)))
    return o.transpose(1, 0, 3, 2, 4).reshape(B, S, MLA_WIDTH)


def setup_inputs(seed: int = 0) -> dict:
    key = jax.random.key(seed)
    ks = jax.random.split(key, 24)
    f32 = jnp.float32
    nrm = lambda k, shape, s: (jax.random.normal(k, shape, f32) * s)
    gain = lambda k, shape: 1.0 + 0.05 * jax.random.normal(k, shape, f32)
    D, F, L = D_MODEL, D_FF, DEPTH
    x = jax.random.normal(ks[0], (BATCH, SEQ, D), f32)
    c = jax.random.normal(ks[1], (BATCH, D), f32)
    positions = jnp.broadcast_to(jnp.arange(SEQ, dtype=jnp.int32)[None, :], (BATCH, SEQ))
    return {
        "x": x,
        "c": c,
        "positions": positions,
        "ada_w": nrm(ks[2], (L, D, 3 * N_SUBLAYERS * D), 0.5 * D ** -0.5),
        "ada_b": nrm(ks[3], (L, 3 * N_SUBLAYERS * D), 0.01),
        "ffn1_norm": gain(ks[4], (L, D)),
        "ffn1_w_gate": nrm(ks[5], (L, D, F), D ** -0.5),
        "ffn1_w_up": nrm(ks[6], (L, D, F), D ** -0.5),
        "ffn1_w_down": nrm(ks[7], (L, F, D), F ** -0.5),
        "mix_norm": gain(ks[8], (L, D)),
        "w_in": nrm(ks[9], (L, D, IN_COLS), D ** -0.5),
        "pool_w": nrm(ks[10], (L, POOL_GROUPS, POOL_GC, POOL_GC), POOL_GC ** -0.5),
        "pool_scale": gain(ks[11], (L, POOL_WIDTH)),
        "q_a_norm": gain(ks[12], (L, Q_LORA)),
        "w_q_b": nrm(ks[13], (L, Q_LORA, N_HEADS * QK_HEAD), Q_LORA ** -0.5),
        "kv_a_norm": gain(ks[14], (L, KV_LORA)),
        "w_kv_b": nrm(ks[15], (L, KV_LORA, N_HEADS * (QK_NOPE + V_HEAD)), KV_LORA ** -0.5),
        "w_out": nrm(ks[16], (L, MIX_WIDTH, D), MIX_WIDTH ** -0.5),
        "ffn2_norm": gain(ks[17], (L, D)),
        "ffn2_w_gate": nrm(ks[18], (L, D, F), D ** -0.5),
        "ffn2_w_up": nrm(ks[19], (L, D, F), D ** -0.5),
        "ffn2_w_down": nrm(ks[20], (L, F, D), F ** -0.5),
        "final_norm": gain(ks[21], (D,)),
    }


def reference(x, c, positions, ada_w, ada_b, ffn1_norm, ffn1_w_gate, ffn1_w_up, ffn1_w_down,
              mix_norm, w_in, pool_w, pool_scale, q_a_norm, w_q_b, kv_a_norm, w_kv_b, w_out,
              ffn2_norm, ffn2_w_gate, ffn2_w_up, ffn2_w_down, final_norm):
    inv_freq = 1.0 / (ROPE_THETA ** (jnp.arange(0, QK_ROPE, 2, dtype=jnp.float32) / QK_ROPE))
    ang = positions.astype(jnp.float32)[..., None] * inv_freq
    ang = jnp.concatenate([ang, ang], axis=-1)
    cos = jnp.cos(ang).astype(x.dtype)
    sin = jnp.sin(ang).astype(x.dtype)
    c_act = jax.nn.silu(c)

    for l in range(DEPTH):
        mod = c_act @ ada_w[l] + ada_b[l]
        (sh1, sc1, g1, sh2, sc2, g2, sh3, sc3, g3) = jnp.split(mod, 3 * N_SUBLAYERS, axis=-1)

        h = modulate(rms_norm(x, ffn1_norm[l]), sh1, sc1)
        x = x + 0.5 * g1[:, None, :] * swiglu(h, ffn1_w_gate[l], ffn1_w_up[l], ffn1_w_down[l])

        h = modulate(rms_norm(x, mix_norm[l]), sh2, sc2)
        z = h @ w_in[l]
        o1 = POOL_WIDTH
        o2 = o1 + Q_LORA
        o3 = o2 + KV_LORA
        y_pool = causal_multiscale_pool(z[..., :o1], pool_w[l], pool_scale[l])
        y_mla = mla_attention(z[..., o1:o2], z[..., o2:o3], z[..., o3:], q_a_norm[l], w_q_b[l],
                              kv_a_norm[l], w_kv_b[l], cos, sin)
        y = jnp.concatenate([y_pool, y_mla], axis=-1) @ w_out[l]
        x = x + g2[:, None, :] * y

        h = modulate(rms_norm(x, ffn2_norm[l]), sh3, sc3)
        x = x + 0.5 * g3[:, None, :] * swiglu(h, ffn2_w_gate[l], ffn2_w_up[l], ffn2_w_down[l])

    return rms_norm(x, final_norm)
```

```cpp
#include <hip/hip_runtime.h>
#include <hip/hip_cooperative_groups.h>
#include <cstdio>
#include <cstdint>
namespace cg = cooperative_groups;

#ifndef MK_ONE_LAUNCH
#define MK_ONE_LAUNCH 1
#endif

#define LAS __attribute__((address_space(3)))
typedef unsigned short bf16_t;
typedef short bf16x8 __attribute__((ext_vector_type(8)));
typedef float f32x4 __attribute__((ext_vector_type(4)));
typedef float f32x2 __attribute__((ext_vector_type(2)));
typedef float f32x16 __attribute__((ext_vector_type(16)));
typedef unsigned u32x4 __attribute__((ext_vector_type(4)));
typedef unsigned u32x2 __attribute__((ext_vector_type(2)));
typedef __bf16 bf16x2_t __attribute__((ext_vector_type(2)));

constexpr int DM = 1024, NBATCH = 8, SEQ = 2048, TT = NBATCH * SEQ, DEPTH = 4, DFF = 2816;
constexpr int NINP = 1280;
constexpr int QLORA = 384, KVLORA = 256, NHEAD = 4, DQK = 192, DNOPE = 128, DROPE = 64, DVH = 128;
constexpr int MODW = 9 * DM;
constexpr float EPS = 1e-6f;
constexpr float QSCALE = 0.07216878364870322f * 1.4426950408889634f;

constexpr size_t MiB = 1u << 20;
constexpr size_t WL_BYTES = 40 * MiB;
constexpr size_t WO_GU1 = 0, WO_D1 = 11534336, WO_GU2 = 17301504, WO_D2 = 28835840, WO_IN = 34603008, WO_Q = 37224448, WO_K = 37814272,
                 WO_V = 38076416, WO_P = 38338560, WO_O = 38862848;
constexpr size_t WS_MOD = 160 * MiB, WS_COS = 162 * MiB, WS_SIN = 164 * MiB, WS_SSQ = 166 * MiB, WS_SSKV = 167 * MiB, WS_HN = 168 * MiB,
                 WS_ACT = 200 * MiB, WS_Z = 288 * MiB, WS_DIFF = 328 * MiB, WS_Q = 344 * MiB, WS_KN = 368 * MiB, WS_KR = 384 * MiB,
                 WS_VT = 386 * MiB, WS_Y = 402 * MiB, WS_END = 434 * MiB;

constexpr int NWAVES = 8, NTHREADS = 512;
constexpr int LDS_BYTES = 147456;

__device__ __forceinline__ unsigned cvtpk(float lo, float hi) { f32x2 v = {lo, hi}; bf16x2_t b = __builtin_convertvector(v, bf16x2_t); return __builtin_bit_cast(unsigned, b); }
__device__ __forceinline__ float bf2f(unsigned short h) { return __builtin_bit_cast(float, (unsigned)h << 16); }
__device__ __forceinline__ float wave_sum(float v) {
#pragma unroll
    for (int o = 1; o < 64; o <<= 1) v += __shfl_xor(v, o);
    return v;
}
__device__ __forceinline__ int lane_id_opaque() { int l; asm volatile("v_mbcnt_lo_u32_b32 %0, -1, 0\n\tv_mbcnt_hi_u32_b32 %0, -1, %0" : "=v"(l)); return l; }
__device__ __forceinline__ float silu_f(float x) { return x / (1.0f + __expf(-x)); }

namespace pg8 {
constexpr int BM = 256, BK = 64, HALF = 128, HTB = HALF * BK * 2, STAGE_BYTES = 8 * HTB, NXCD = 8, WGM = 8;
__host__ __device__ __forceinline__ int lds_byte(int r, int c) { const int st = (r >> 4) * 2 + (c >> 5), rr = r & 15, cc = c & 31, ob = rr * 64 + cc * 2; return st * 1024 + (ob ^ (((ob >> 9) & 1) << 5)); }
__host__ __device__ __forceinline__ void stage_rc(int b, int& R, int& C) { const int st = b / 1024, sb = b % 1024, swz = sb ^ (((sb >> 9) & 1) << 5); R = (st >> 1) * 16 + swz / 64; C = (st & 1) * 32 + (swz % 64) / 2; }
__host__ __device__ __forceinline__ int perm32(int rho) { const int n = rho >> 4, i = rho & 15; return 8 * (i >> 2) + 4 * n + (i & 3); }

struct Unit { int pm, pn; };
struct Gemm { const bf16_t* A; const bf16_t* Bt; int M, N, K, lda, ldb; };

struct StaticOrder {
    int nM, nN, nwg, G, c;
    __host__ __device__ void init(int M, int N, int G_, int c_) { nM = M / BM; nN = N / BM; nwg = nM * nN; G = G_; c = c_; }
    __host__ __device__ bool next(int i, Unit& u) const {
        const long L = (long)i * G + c; if (L >= nwg) return false;
        int wgid = (int)L; { const int q = nwg / NXCD, r = nwg % NXCD, xcd = wgid % NXCD, off = wgid / NXCD; wgid = (xcd < r ? xcd * (q + 1) : r * (q + 1) + (xcd - r) * q) + off; }
        const int nig = WGM * nN, gid = wgid / nig, fm = gid * WGM, gsz = (nM - fm) < WGM ? (nM - fm) : WGM;
        u.pm = fm + ((wgid % nig) % gsz); u.pn = (wgid % nig) / gsz; return true;
    }
};

template <class Epi, bool ALIGN_EPI>
__device__ __forceinline__ void gemm_phase(LAS unsigned char* lds, const Gemm g, const StaticOrder& S, const Epi& E, const int tid_l) {
    const int tid = tid_l, wid = __builtin_amdgcn_readfirstlane(tid >> 6), lane = tid & 63, wr = wid >> 2, wc = wid & 3, fr = lane & 15, fq = lane >> 4;
    const int K = g.K, nt = K / BK;
    unsigned voffA[2], voffB[2];
#pragma unroll
    for (int i = 0; i < 2; ++i) { int R, C; stage_rc(tid * 16 + i * 8192, R, C); const int Rb = Epi::PERM ? ((R & ~31) + perm32(R & 31)) : R;
        voffA[i] = (unsigned)(R * g.lda + C) * 2u; voffB[i] = (unsigned)(Rb * g.ldb + C) * 2u; }
    const size_t kstep = (size_t)(BK * 2);
    const size_t hstepA = (size_t)HALF * g.lda * 2, hstepB = (size_t)HALF * g.ldb * 2;
    const size_t tstepA = 2 * hstepA, tstepB = 2 * hstepB;
    const unsigned ldsw = (unsigned)wid * 1024u;
    const int aoff = lds_byte(wr * 64 + fr, fq * 8), boff = lds_byte(wc * 32 + fr, fq * 8);
#define PG8_SA(b, h) (((b) * 2 + (h)) * HTB)
#define PG8_SB(b, h) ((4 + (b) * 2 + (h)) * HTB)
#define PG8_STAGE(bufoff, gbase, voff) do { _Pragma("unroll") for (int _i = 0; _i < 2; ++_i) \
        __builtin_amdgcn_global_load_lds((const unsigned*)((const char*)(gbase) + (voff)[_i]), (LAS unsigned*)(lds + (bufoff) + ldsw + _i * 8192), 16, 0, 0); } while (0)
#define PG8_LDA(dst, b, h) do { _Pragma("unroll") for (int m = 0; m < 4; ++m) _Pragma("unroll") for (int k = 0; k < 2; ++k) dst[m][k] = *(const LAS bf16x8*)(lds + PG8_SA(b, h) + aoff + m * 2048 + k * 1024); } while (0)
#define PG8_LDB(dst, b, h) do { _Pragma("unroll") for (int n = 0; n < 2; ++n) _Pragma("unroll") for (int k = 0; k < 2; ++k) dst[n][k] = *(const LAS bf16x8*)(lds + PG8_SB(b, h) + boff + n * 2048 + k * 1024); } while (0)
#define PG8_MMA(ai, bj, At, Bt) do { __builtin_amdgcn_s_setprio(1); _Pragma("unroll") for (int m = 0; m < 4; ++m) _Pragma("unroll") for (int n = 0; n < 2; ++n) _Pragma("unroll") for (int k = 0; k < 2; ++k) \
        acc[ai][bj][m][n] = __builtin_amdgcn_mfma_f32_16x16x32_bf16(Bt[n][k], At[m][k], acc[ai][bj][m][n], 0, 0, 0); __builtin_amdgcn_s_setprio(0); } while (0)
#define PG8_WAIT_V(n) asm volatile("s_waitcnt vmcnt(" #n ")" ::: "memory")
#define PG8_WAIT_L(n) asm volatile("s_waitcnt lgkmcnt(" #n ")" ::: "memory")
#define PG8_BAR __builtin_amdgcn_s_barrier()
#define PG8_SCHED __builtin_amdgcn_sched_barrier(0)
    Unit cur, nxt; int ui = 0;
    if (!S.next(0, cur)) return;
    f32x4 acc[2][2][4][2];
#pragma unroll
    for (int a = 0; a < 2; ++a)
#pragma unroll
        for (int b = 0; b < 2; ++b)
#pragma unroll
            for (int m = 0; m < 4; ++m)
#pragma unroll
                for (int n = 0; n < 2; ++n) acc[a][b][m][n] = (f32x4){0.f, 0.f, 0.f, 0.f};
    bf16x8 At[4][2], B0[2][2], B1[2][2];
    const char* cA = (const char*)g.A + (size_t)cur.pm * tstepA; const char* cB = (const char*)g.Bt + (size_t)cur.pn * tstepB;
    PG8_STAGE(PG8_SB(0, 0), cB, voffB); PG8_STAGE(PG8_SB(0, 1), cB + hstepB, voffB); PG8_STAGE(PG8_SA(0, 0), cA, voffA); PG8_STAGE(PG8_SA(0, 1), cA + hstepA, voffA);
    if (wr == 1) PG8_BAR;
    PG8_WAIT_V(2); PG8_BAR;
    PG8_STAGE(PG8_SB(1, 0), cB + kstep, voffB); PG8_STAGE(PG8_SA(1, 0), cA + kstep, voffA); PG8_STAGE(PG8_SB(1, 1), cB + hstepB + kstep, voffB);
    PG8_WAIT_V(6); PG8_BAR;
    for (;;) {
        const bool has_next = S.next(ui + 1, nxt);
        const char* nA = has_next ? (const char*)g.A + (size_t)nxt.pm * tstepA : cA; const char* nB = has_next ? (const char*)g.Bt + (size_t)nxt.pn * tstepB : cB;
        for (int t = 0; t < nt; t += 2) {
            const bool last = (t == nt - 2);
            const char* a1 = cA + (size_t)(t + 1) * kstep;
            const char* a2 = last ? nA : cA + (size_t)(t + 2) * kstep; const char* b2 = last ? nB : cB + (size_t)(t + 2) * kstep;
            const char* a3 = a2 + kstep; const char* b3 = b2 + kstep;
            PG8_LDB(B0, 0, 0); PG8_LDB(B1, 0, 1); PG8_SCHED; PG8_LDA(At, 0, 0); PG8_STAGE(PG8_SA(1, 1), a1 + hstepA, voffA);
            PG8_WAIT_V(8); PG8_WAIT_L(0); PG8_BAR; PG8_MMA(0, 0, At, B0); PG8_MMA(0, 1, At, B1); PG8_BAR; PG8_SCHED;
            PG8_LDA(At, 0, 1); PG8_STAGE(PG8_SB(0, 0), b2, voffB); PG8_STAGE(PG8_SB(0, 1), b2 + hstepB, voffB); PG8_STAGE(PG8_SA(0, 0), a2, voffA);
            PG8_WAIT_V(8); PG8_WAIT_L(0); PG8_BAR; PG8_MMA(1, 0, At, B0); PG8_MMA(1, 1, At, B1); PG8_BAR; PG8_SCHED;
            PG8_LDB(B0, 1, 0); PG8_LDB(B1, 1, 1); PG8_SCHED; PG8_LDA(At, 1, 0); PG8_STAGE(PG8_SA(0, 1), a2 + hstepA, voffA);
            PG8_WAIT_V(8); PG8_WAIT_L(0); PG8_BAR; PG8_MMA(0, 0, At, B0); PG8_MMA(0, 1, At, B1); PG8_BAR; PG8_SCHED;
            PG8_LDA(At, 1, 1); PG8_STAGE(PG8_SB(1, 0), b3, voffB); PG8_STAGE(PG8_SB(1, 1), b3 + hstepB, voffB); PG8_STAGE(PG8_SA(1, 0), a3, voffA);
            PG8_WAIT_V(8); PG8_WAIT_L(0); PG8_BAR; PG8_MMA(1, 0, At, B0); PG8_MMA(1, 1, At, B1); PG8_BAR; PG8_SCHED;
        }
        if constexpr (ALIGN_EPI) { if (wr == 0) PG8_BAR; }
        { const int le = lane_id_opaque(); E(acc, cur, wr, wc, le & 15, le >> 4); }
        if (!has_next) break;
#pragma unroll
        for (int a = 0; a < 2; ++a)
#pragma unroll
            for (int b = 0; b < 2; ++b)
#pragma unroll
                for (int m = 0; m < 4; ++m)
#pragma unroll
                    for (int n = 0; n < 2; ++n) acc[a][b][m][n] = (f32x4){0.f, 0.f, 0.f, 0.f};
        cur = nxt; cA = nA; cB = nB; ++ui;
        if constexpr (ALIGN_EPI) { if (wr == 1) PG8_BAR; }
    }
    PG8_WAIT_V(0);
    if constexpr (!ALIGN_EPI) { if (wr == 0) PG8_BAR; }
    PG8_BAR;
#undef PG8_SA
#undef PG8_SB
#undef PG8_STAGE
#undef PG8_LDA
#undef PG8_LDB
#undef PG8_MMA
#undef PG8_WAIT_V
#undef PG8_WAIT_L
#undef PG8_BAR
#undef PG8_SCHED
}
}

typedef f32x4 Acc[2][2][4][2];

struct EpiSwiglu {
    static constexpr bool PERM = true;
    bf16_t* act;
    __device__ __forceinline__ void operator()(const Acc& acc, const pg8::Unit& u, int wr, int wc, int fr, int fq) const {
        const int row0 = u.pm * 256 + wr * 64 + fr, col = u.pn * 128 + wc * 32 + 8 * fq;
#pragma unroll
        for (int ai = 0; ai < 2; ++ai)
#pragma unroll
            for (int m = 0; m < 4; ++m) {
                const f32x4 g0 = acc[ai][0][m][0], g1 = acc[ai][0][m][1], u0 = acc[ai][1][m][0], u1 = acc[ai][1][m][1];
                float a[8];
#pragma unroll
                for (int j = 0; j < 4; ++j) { a[j] = silu_f(g0[j]) * u0[j]; a[4 + j] = silu_f(g1[j]) * u1[j]; }
                u32x4 w; w.x = cvtpk(a[0], a[1]); w.y = cvtpk(a[2], a[3]); w.z = cvtpk(a[4], a[5]); w.w = cvtpk(a[6], a[7]);
                *(u32x4*)(act + (size_t)(row0 + ai * 128 + m * 16) * DFF + col) = w;
            }
    }
};
struct EpiResid {
    static constexpr bool PERM = false;
    const float* base; float* out; const float* gate; float coef;
    __device__ __forceinline__ void operator()(const Acc& acc, const pg8::Unit& u, int wr, int wc, int fr, int fq) const {
        const int row0 = u.pm * 256 + wr * 64 + fr, col0 = u.pn * 256 + wc * 32 + 4 * fq;
        const int b = (u.pm * 256) / SEQ;
        f32x4 gv[2][2];
#pragma unroll
        for (int bj = 0; bj < 2; ++bj)
#pragma unroll
            for (int n = 0; n < 2; ++n) gv[bj][n] = *(const f32x4*)(gate + (size_t)b * MODW + col0 + bj * 128 + n * 16) * coef;
#pragma unroll
        for (int ai = 0; ai < 2; ++ai)
#pragma unroll
            for (int m = 0; m < 4; ++m) { const size_t off = (size_t)(row0 + ai * 128 + m * 16) * DM + col0;
#pragma unroll
                for (int bj = 0; bj < 2; ++bj)
#pragma unroll
                    for (int n = 0; n < 2; ++n) { const f32x4 bs = *(const f32x4*)(base + off + bj * 128 + n * 16);
                        *(f32x4*)(out + off + bj * 128 + n * 16) = bs + gv[bj][n] * acc[ai][bj][m][n]; }
                if (m & 1) asm volatile("" ::: "memory"); }
    }
};
struct EpiIn {
    static constexpr bool PERM = true;
    bf16_t* z; float* ssq; float* sskv; bf16_t* kr; const float* cosT; const float* sinT;
    __device__ __forceinline__ void operator()(const Acc& acc, const pg8::Unit& u, int wr, int wc, int fr, int fq) const {
        const int row0 = u.pm * 256 + wr * 64 + fr;
#pragma unroll
        for (int bj = 0; bj < 2; ++bj) {
            const int cg0 = u.pn * 256 + bj * 128 + wc * 32;
            if (cg0 >= 1216) continue;
            if (cg0 >= 1152) {
                const int i0 = ((cg0 - 1152) >> 5) * 16 + 4 * fq;
#pragma unroll
                for (int ai = 0; ai < 2; ++ai)
#pragma unroll
                    for (int m = 0; m < 4; ++m) { const int row = row0 + ai * 128 + m * 16;
                        const f32x4 c = *(const f32x4*)(cosT + (size_t)row * 32 + i0), s = *(const f32x4*)(sinT + (size_t)row * 32 + i0);
                        const f32x4 x1 = acc[ai][bj][m][0], x2 = acc[ai][bj][m][1];
                        const f32x4 o1 = x1 * c - x2 * s, o2 = x2 * c + x1 * s;
                        u32x2 w1, w2; w1.x = cvtpk(o1[0], o1[1]); w1.y = cvtpk(o1[2], o1[3]); w2.x = cvtpk(o2[0], o2[1]); w2.y = cvtpk(o2[2], o2[3]);
                        *(u32x2*)(kr + (size_t)row * DROPE + i0) = w1; *(u32x2*)(kr + (size_t)row * DROPE + 32 + i0) = w2; }
                continue;
            }
            float* ssp = nullptr; int slot = 0, nsl = 0;
            if (cg0 >= 896) { ssp = sskv; slot = (cg0 - 896) >> 5; nsl = 8; } else if (cg0 >= 512) { ssp = ssq; slot = (cg0 - 512) >> 5; nsl = 12; }
#pragma unroll
            for (int ai = 0; ai < 2; ++ai)
#pragma unroll
                for (int m = 0; m < 4; ++m) { const int row = row0 + ai * 128 + m * 16;
                    const f32x4 v0 = acc[ai][bj][m][0], v1 = acc[ai][bj][m][1];
                    u32x4 w; w.x = cvtpk(v0[0], v0[1]); w.y = cvtpk(v0[2], v0[3]); w.z = cvtpk(v1[0], v1[1]); w.w = cvtpk(v1[2], v1[3]);
                    *(u32x4*)(z + (size_t)row * NINP + cg0 + 8 * fq) = w;
                    if (ssp) { float q = (v0[0] * v0[0] + v0[1] * v0[1]) + (v0[2] * v0[2] + v0[3] * v0[3]) + (v1[0] * v1[0] + v1[1] * v1[1]) + (v1[2] * v1[2] + v1[3] * v1[3]);
                        q += __shfl_xor(q, 16); q += __shfl_xor(q, 32);
                        if (fq == 0) ssp[(size_t)row * nsl + slot] = q; } }
        }
    }
};
__device__ __forceinline__ float row_rs12(const float* p) { const f32x4 a = *(const f32x4*)p, b = *(const f32x4*)(p + 4), c = *(const f32x4*)(p + 8);
    const float s = ((a[0] + a[1]) + (a[2] + a[3])) + ((b[0] + b[1]) + (b[2] + b[3])) + ((c[0] + c[1]) + (c[2] + c[3])); return __builtin_amdgcn_rsqf(s * (1.0f / QLORA) + EPS); }
__device__ __forceinline__ float row_rs8(const float* p) { const f32x4 a = *(const f32x4*)p, b = *(const f32x4*)(p + 4);
    const float s = ((a[0] + a[1]) + (a[2] + a[3])) + ((b[0] + b[1]) + (b[2] + b[3])); return __builtin_amdgcn_rsqf(s * (1.0f / KVLORA) + EPS); }
struct EpiQ {
    static constexpr bool PERM = true;
    bf16_t* q; const LAS float* rst; const float* cosT; const float* sinT;
    __device__ __forceinline__ void operator()(const Acc& acc, const pg8::Unit& u, int wr, int wc, int fr, int fq) const {
        const int row0 = u.pm * 256 + wr * 64 + fr;
#pragma unroll
        for (int ai = 0; ai < 2; ++ai)
#pragma unroll
            for (int m = 0; m < 4; ++m) { const int row = row0 + ai * 128 + m * 16;
                const float rs = rst[ai * 128 + wr * 64 + m * 16 + fr];
#pragma unroll
                for (int bj = 0; bj < 2; ++bj) {
                    const int cg0 = u.pn * 256 + bj * 128 + wc * 32, head = cg0 / DQK, within = cg0 - head * DQK;
                    const f32x4 x1 = acc[ai][bj][m][0] * rs, x2 = acc[ai][bj][m][1] * rs;
                    if (within < DNOPE) { u32x4 w; w.x = cvtpk(x1[0], x1[1]); w.y = cvtpk(x1[2], x1[3]); w.z = cvtpk(x2[0], x2[1]); w.w = cvtpk(x2[2], x2[3]);
                        *(u32x4*)(q + (size_t)row * 768 + cg0 + 8 * fq) = w; }
                    else { const int i0 = ((within - DNOPE) >> 5) * 16 + 4 * fq;
                        const f32x4 c = *(const f32x4*)(cosT + (size_t)row * 32 + i0), s = *(const f32x4*)(sinT + (size_t)row * 32 + i0);
                        const f32x4 o1 = x1 * c - x2 * s, o2 = x2 * c + x1 * s;
                        u32x2 w1, w2; w1.x = cvtpk(o1[0], o1[1]); w1.y = cvtpk(o1[2], o1[3]); w2.x = cvtpk(o2[0], o2[1]); w2.y = cvtpk(o2[2], o2[3]);
                        bf16_t* qp = q + (size_t)row * 768 + head * DQK + DNOPE + i0;
                        *(u32x2*)qp = w1; *(u32x2*)(qp + 32) = w2; } }
                asm volatile("" ::: "memory"); }
    }
};
struct EpiK {
    static constexpr bool PERM = true;
    bf16_t* kn; const LAS float* rst;
    __device__ __forceinline__ void operator()(const Acc& acc, const pg8::Unit& u, int wr, int wc, int fr, int fq) const {
        const int row0 = u.pm * 256 + wr * 64 + fr, col0 = u.pn * 256 + wc * 32 + 8 * fq;
#pragma unroll
        for (int ai = 0; ai < 2; ++ai)
#pragma unroll
            for (int m = 0; m < 4; ++m) { const int row = row0 + ai * 128 + m * 16;
                const float rs = rst[ai * 128 + wr * 64 + m * 16 + fr];
#pragma unroll
                for (int bj = 0; bj < 2; ++bj) { const f32x4 x1 = acc[ai][bj][m][0] * rs, x2 = acc[ai][bj][m][1] * rs;
                    u32x4 w; w.x = cvtpk(x1[0], x1[1]); w.y = cvtpk(x1[2], x1[3]); w.z = cvtpk(x2[0], x2[1]); w.w = cvtpk(x2[2], x2[3]);
                    *(u32x4*)(kn + (size_t)row * 512 + col0 + bj * 128) = w; }
                asm volatile("" ::: "memory"); }
    }
};
struct EpiVt {
    static constexpr bool PERM = true;
    bf16_t* vt; const LAS float* rst;
    __device__ __forceinline__ void operator()(const Acc& acc, const pg8::Unit& u, int wr, int wc, int fr, int fq) const {
        const int row0 = u.pm * 256 + wr * 64 + fr;
        const int t0 = u.pn * 256 + wc * 32 + 8 * fq;
        const int b = (u.pn * 256) / SEQ, s0 = t0 - b * SEQ;
#pragma unroll
        for (int bj = 0; bj < 2; ++bj) {
            const f32x4 ra = *(const LAS f32x4*)(rst + bj * 128 + wc * 32 + 8 * fq), rb = *(const LAS f32x4*)(rst + bj * 128 + wc * 32 + 8 * fq + 4);
            const float rs[8] = {ra[0], ra[1], ra[2], ra[3], rb[0], rb[1], rb[2], rb[3]};
#pragma unroll
            for (int ai = 0; ai < 2; ++ai)
#pragma unroll
                for (int m = 0; m < 4; ++m) { const int r = row0 + ai * 128 + m * 16;
                    const f32x4 x1 = acc[ai][bj][m][0], x2 = acc[ai][bj][m][1];
                    u32x4 w; w.x = cvtpk(x1[0] * rs[0], x1[1] * rs[1]); w.y = cvtpk(x1[2] * rs[2], x1[3] * rs[3]); w.z = cvtpk(x2[0] * rs[4], x2[1] * rs[5]); w.w = cvtpk(x2[2] * rs[6], x2[3] * rs[7]);
                    *(u32x4*)(vt + ((size_t)b * 512 + r) * SEQ + s0 + bj * 128) = w; }
        }
    }
};
struct EpiPool {
    static constexpr bool PERM = true;
    bf16_t* y; const float* ps;
    __device__ __forceinline__ void operator()(const Acc& acc, const pg8::Unit& u, int wr, int wc, int fr, int fq) const {
        const int row0 = u.pm * 256 + wr * 64 + fr, col0 = u.pn * 256 + wc * 32 + 8 * fq;
#pragma unroll
        for (int bj = 0; bj < 2; ++bj) { const f32x4 p0 = *(const f32x4*)(ps + col0 + bj * 128), p1 = *(const f32x4*)(ps + col0 + bj * 128 + 4);
#pragma unroll
            for (int ai = 0; ai < 2; ++ai)
#pragma unroll
                for (int m = 0; m < 4; ++m) { const int row = row0 + ai * 128 + m * 16;
                    const f32x4 x1 = acc[ai][bj][m][0] * p0, x2 = acc[ai][bj][m][1] * p1;
                    u32x4 w; w.x = cvtpk(x1[0], x1[1]); w.y = cvtpk(x1[2], x1[3]); w.z = cvtpk(x2[0], x2[1]); w.w = cvtpk(x2[2], x2[3]);
                    *(u32x4*)(y + (size_t)row * DM + col0 + bj * 128) = w; } }
    }
};

constexpr int AK_ROWB = 400, AK_TILEB = 64 * AK_ROWB;
constexpr int AV_ROWB = 144, AV_TILEB = 128 * AV_ROWB;
constexpr int ALDS_K = 0, ALDS_V = 2 * AK_TILEB, ALDS_Q = ALDS_V + 2 * AV_TILEB;
__device__ __forceinline__ int crow(int r, int hi) { return (r & 3) + 8 * (r >> 2) + 4 * hi; }
#define MFMA32(a, b, c) __builtin_amdgcn_mfma_f32_32x32x16_bf16((a), (b), (c), 0, 0, 0)

__device__ __forceinline__ void attn_unit(LAS unsigned char* lds, const bf16_t* __restrict__ Q, const bf16_t* __restrict__ KN, const bf16_t* __restrict__ KR,
                                          const bf16_t* __restrict__ VT, bf16_t* __restrict__ Y, int b, int h, int u, const int tid_l) {
    const int tid = tid_l, lane = tid & 63, wid = __builtin_amdgcn_readfirstlane(tid >> 6), rg = wid & 3, g = wid >> 2, ql = lane & 31, hi = lane >> 5;
    const int q0 = 128 * u + 32 * rg;
    const size_t tb = (size_t)b * SEQ;
    const LAS unsigned char* qfl = lds + ALDS_Q + rg * (32 * AK_ROWB) + ql * AK_ROWB + hi * 16;
    if (g == 0) { const bf16_t* qp = Q + (tb + q0 + ql) * 768 + h * DQK + 8 * hi;
#pragma unroll
      for (int s = 0; s < 12; ++s) *(LAS bf16x8*)(lds + ALDS_Q + rg * (32 * AK_ROWB) + ql * AK_ROWB + hi * 16 + s * 32) = *(const bf16x8*)(qp + 16 * s); }
    f32x16 oT[4];
#pragma unroll
    for (int d = 0; d < 4; ++d)
#pragma unroll
        for (int r = 0; r < 16; ++r) oT[d][r] = 0.f;
    float mrun = -1e30f, lrun = 0.f;
    const int nsteps = u + 1;
    const bf16_t* knp = KN + (tb + (tid >> 4)) * 512 + h * 128 + 8 * (tid & 15);
    const bf16_t* krp = KR + (tb + (tid >> 3)) * DROPE + 8 * (tid & 7);
    const bf16_t* vtp = VT + ((size_t)((b * 4 + h) * 128 + (tid >> 3))) * SEQ + 8 * (tid & 7);
    const unsigned kndst = ALDS_K + (tid >> 4) * AK_ROWB + (tid & 15) * 16, krdst = ALDS_K + (tid >> 3) * AK_ROWB + 256 + (tid & 7) * 16, vdst = ALDS_V + (tid >> 3) * AV_ROWB + (tid & 7) * 16;
    u32x4 kreg[6], vreg[4];
#define A_LOAD(j) do { _Pragma("unroll") for (int i = 0; i < 4; ++i) kreg[i] = *(const u32x4*)(knp + ((size_t)(j) * 128 + 64 * (i >> 1) + 32 * (i & 1)) * 512); \
                       _Pragma("unroll") for (int i = 0; i < 2; ++i) kreg[4 + i] = *(const u32x4*)(krp + ((size_t)(j) * 128 + 64 * i) * DROPE); \
                       _Pragma("unroll") for (int i = 0; i < 4; ++i) vreg[i] = *(const u32x4*)(vtp + (size_t)(64 * (i & 1)) * SEQ + (j) * 128 + 64 * (i >> 1)); } while (0)
#define A_STORE() do { _Pragma("unroll") for (int i = 0; i < 4; ++i) *(LAS u32x4*)(lds + kndst + (i >> 1) * AK_TILEB + 32 * (i & 1) * AK_ROWB) = kreg[i]; \
                       _Pragma("unroll") for (int i = 0; i < 2; ++i) *(LAS u32x4*)(lds + krdst + i * AK_TILEB) = kreg[4 + i]; \
                       _Pragma("unroll") for (int i = 0; i < 4; ++i) *(LAS u32x4*)(lds + vdst + (i >> 1) * AV_TILEB + 64 * (i & 1) * AV_ROWB) = vreg[i]; } while (0)
    A_LOAD(0); A_STORE(); __syncthreads();
    const LAS unsigned char* kt = lds + ALDS_K + g * AK_TILEB + ql * AK_ROWB + hi * 16;
    const LAS unsigned char* vtl = lds + ALDS_V + g * AV_TILEB + ql * AV_ROWB + hi * 8;
    for (int j = 0; j < nsteps; ++j) {
        if (j + 1 < nsteps) A_LOAD(j + 1);
        const int key0 = 64 * (2 * j + g);
        if (key0 <= q0 + 31) {
            f32x16 s0, s1;
#pragma unroll
            for (int r = 0; r < 16; ++r) { s0[r] = 0.f; s1[r] = 0.f; }
#pragma unroll
            for (int s = 0; s < 12; ++s) { const bf16x8 a0 = *(const LAS bf16x8*)(kt + s * 32), a1 = *(const LAS bf16x8*)(kt + 32 * AK_ROWB + s * 32), qv = *(const LAS bf16x8*)(qfl + s * 32);
                s0 = MFMA32(a0, qv, s0); s1 = MFMA32(a1, qv, s1); }
            if (key0 + 63 > q0) { const int qpos = q0 + ql;
#pragma unroll
                for (int r = 0; r < 16; ++r) { const int kk = key0 + crow(r, hi); if (kk > qpos) s0[r] = -INFINITY; if (kk + 32 > qpos) s1[r] = -INFINITY; } }
            float mx = fmaxf(s0[0], s1[0]);
#pragma unroll
            for (int r = 1; r < 16; ++r) mx = fmaxf(mx, fmaxf(s0[r], s1[r]));
            mx = fmaxf(mx, __shfl_xor(mx, 32));
            const float mn = fmaxf(mrun, mx), alpha = __builtin_amdgcn_exp2f(mrun - mn); mrun = mn;
            float ls = 0.f;
#pragma unroll
            for (int r = 0; r < 16; ++r) { s0[r] = __builtin_amdgcn_exp2f(s0[r] - mn); s1[r] = __builtin_amdgcn_exp2f(s1[r] - mn); ls += s0[r] + s1[r]; }
            lrun = lrun * alpha + ls;
#pragma unroll
            for (int d = 0; d < 4; ++d)
#pragma unroll
                for (int r = 0; r < 16; ++r) oT[d][r] *= alpha;
            bf16x8 pb[2][2];
#pragma unroll
            for (int sp = 0; sp < 2; ++sp) { u32x4 w0, w1;
                w0.x = cvtpk(s0[8 * sp + 0], s0[8 * sp + 1]); w0.y = cvtpk(s0[8 * sp + 2], s0[8 * sp + 3]); w0.z = cvtpk(s0[8 * sp + 4], s0[8 * sp + 5]); w0.w = cvtpk(s0[8 * sp + 6], s0[8 * sp + 7]);
                w1.x = cvtpk(s1[8 * sp + 0], s1[8 * sp + 1]); w1.y = cvtpk(s1[8 * sp + 2], s1[8 * sp + 3]); w1.z = cvtpk(s1[8 * sp + 4], s1[8 * sp + 5]); w1.w = cvtpk(s1[8 * sp + 6], s1[8 * sp + 7]);
                pb[0][sp] = __builtin_bit_cast(bf16x8, w0); pb[1][sp] = __builtin_bit_cast(bf16x8, w1); }
#pragma unroll
            for (int d = 0; d < 4; ++d)
#pragma unroll
                for (int kb = 0; kb < 2; ++kb)
#pragma unroll
                    for (int sp = 0; sp < 2; ++sp) { const LAS unsigned char* vp = vtl + d * 32 * AV_ROWB + (32 * kb + 16 * sp) * 2;
                        const u32x2 lo = *(const LAS u32x2*)vp, hh = *(const LAS u32x2*)(vp + 16);
                        u32x4 a; a.x = lo.x; a.y = lo.y; a.z = hh.x; a.w = hh.y;
                        oT[d] = MFMA32(__builtin_bit_cast(bf16x8, a), pb[kb][sp], oT[d]); }
        }
        __syncthreads();
        if (j + 1 < nsteps) A_STORE();
        __syncthreads();
    }
#undef A_LOAD
#undef A_STORE
    LAS float* mo = (LAS float*)lds;
    LAS float* ml = (LAS float*)(lds + 65536);
    if (g == 1) {
#pragma unroll
        for (int d = 0; d < 4; ++d)
#pragma unroll
            for (int r = 0; r < 16; ++r) mo[(rg * 64 + d * 16 + r) * 64 + lane] = oT[d][r];
        ml[(rg * 2 + 0) * 64 + lane] = mrun; ml[(rg * 2 + 1) * 64 + lane] = lrun;
    }
    __syncthreads();
    if (g == 0) {
        const float m1 = ml[(rg * 2 + 0) * 64 + lane], l1 = ml[(rg * 2 + 1) * 64 + lane];
        const float mn = fmaxf(mrun, m1), f0 = __builtin_amdgcn_exp2f(mrun - mn), f1 = __builtin_amdgcn_exp2f(m1 - mn);
        float lt = lrun * f0 + l1 * f1; lt += __shfl_xor(lt, 32);
        const float inv = 1.0f / lt, c0 = f0 * inv, c1 = f1 * inv;
        bf16_t* yp = Y + (tb + q0 + ql) * DM + 512 + h * DVH + 4 * hi;
#pragma unroll
        for (int d = 0; d < 4; ++d)
#pragma unroll
            for (int r4 = 0; r4 < 4; ++r4) { float o[4];
#pragma unroll
                for (int e = 0; e < 4; ++e) { const int r = 4 * r4 + e; o[e] = oT[d][r] * c0 + mo[(rg * 64 + d * 16 + r) * 64 + lane] * c1; }
                u32x2 w; w.x = cvtpk(o[0], o[1]); w.y = cvtpk(o[2], o[3]);
                *(u32x2*)(yp + 32 * d + 8 * r4) = w; }
    }
    __syncthreads();
}

struct Params {
    const float* x; const float* c; const int* pos; const float* ada_w; const float* ada_b;
    const float* ffn1_norm; const float* ffn1_wg; const float* ffn1_wu; const float* ffn1_wd;
    const float* mix_norm; const float* w_in; const float* pool_w; const float* pool_scale;
    const float* q_a_norm; const float* w_q_b; const float* kv_a_norm; const float* w_kv_b; const float* w_out;
    const float* ffn2_norm; const float* ffn2_wg; const float* ffn2_wu; const float* ffn2_wd; const float* final_norm;
    float* out; unsigned char* ws; int ph_lo, ph_hi;
};

struct ColMap { const float* p; };
template <class MapF>
__device__ __forceinline__ void conv_items(MapF mapf, int K, int Nout, int ldw, const float* gain, bf16_t* WT, LAS float* scr, int gw, int NGW, int lane, int& base) {
    const int nblk = Nout / 32, nitems = (K / 64) * nblk;
    int start = (gw - (base % NGW) + NGW) % NGW;
    for (int it = start; it < nitems; it += NGW) {
        const int kb = it / nblk, nb = it - kb * nblk, k0 = 64 * kb, n0 = 32 * nb;
        const float* src = mapf(n0 + (lane & 31));
#pragma unroll 8
        for (int i = 0; i < 32; ++i) { const int kk = 2 * i + (lane >> 5); float v = src ? src[(size_t)(k0 + kk) * ldw] : 0.f; if (gain) v *= gain[k0 + kk]; scr[kk * 33 + (lane & 31)] = v; }
        asm volatile("s_waitcnt lgkmcnt(0)" ::: "memory");
        const int c = lane & 7;
#pragma unroll
        for (int j = 0; j < 4; ++j) { const int n = (lane >> 3) + 8 * j; const LAS float* s = scr + (8 * c) * 33 + n;
            u32x4 o; o.x = cvtpk(s[0 * 33], s[1 * 33]); o.y = cvtpk(s[2 * 33], s[3 * 33]); o.z = cvtpk(s[4 * 33], s[5 * 33]); o.w = cvtpk(s[6 * 33], s[7 * 33]);
            *(u32x4*)(WT + (size_t)(n0 + n) * K + k0 + 8 * c) = o; }
        asm volatile("s_waitcnt lgkmcnt(0)" ::: "memory");
    }
    base += nitems;
}
__device__ __forceinline__ int rope_dim(int p) { const int g = p >> 5, rho = p & 31; return 16 * g + 4 * (rho >> 3) + (rho & 3) + 32 * ((rho >> 2) & 1); }

typedef const __attribute__((address_space(4))) struct Params* KArgsP;
__device__ __forceinline__ void prologue(KArgsP PP, LAS unsigned char* lds, const int tid_l) {
#define P (*PP)
    const int tid = tid_l, lane = tid & 63, wave = __builtin_amdgcn_readfirstlane(tid >> 6);
    const int G = gridDim.x, gw = blockIdx.x * NWAVES + wave, NGW = G * NWAVES;
    unsigned char* ws = P.ws;
    {
        LAS float* ca = (LAS float*)lds;
        LAS float* red = (LAS float*)(lds + 32768);
        for (int i = tid; i < NBATCH * DM; i += NTHREADS) ca[i] = silu_f(P.c[i]);
        __syncthreads();
        float* mod = (float*)(ws + WS_MOD);
        for (int it = blockIdx.x; it < DEPTH * (MODW / 64); it += G) {
            const int l = it / (MODW / 64), n0 = (it - l * (MODW / 64)) * 64;
            const float* W = P.ada_w + (size_t)l * DM * MODW + n0 + lane;
            float a[8];
#pragma unroll
            for (int b = 0; b < 8; ++b) a[b] = 0.f;
            const int kb0 = wave * 128;
#pragma unroll 8
            for (int k = 0; k < 128; ++k) { const float w = W[(size_t)(kb0 + k) * MODW];
#pragma unroll
                for (int b = 0; b < 8; ++b) a[b] += ca[b * DM + kb0 + k] * w; }
#pragma unroll
            for (int b = 0; b < 8; ++b) red[(wave * 8 + b) * 64 + lane] = a[b];
            __syncthreads();
            { float s = 0.f;
#pragma unroll
              for (int w = 0; w < 8; ++w) s += red[(w * 8 + wave) * 64 + lane];
              mod[((size_t)l * NBATCH + wave) * MODW + n0 + lane] = s + P.ada_b[(size_t)l * MODW + n0 + lane]; }
            __syncthreads();
        }
    }
    {
        float* cosT = (float*)(ws + WS_COS); float* sinT = (float*)(ws + WS_SIN);
        for (int i = blockIdx.x * NTHREADS + tid; i < TT * 32; i += G * NTHREADS) {
            const int t = i >> 5, d = i & 31;
            const float invf = 1.0f / powf(10000.0f, (float)(2 * d) * (1.0f / 64.0f));
            const float ang = (float)P.pos[t] * invf;
            const double rev = (double)ang * 0.15915494309189535; const float fr = (float)(rev - floor(rev));
            cosT[i] = __builtin_amdgcn_cosf(fr); sinT[i] = __builtin_amdgcn_sinf(fr);
        }
    }
    {
        LAS float* scr = (LAS float*)(lds + 65536 + wave * 8704);
        int base = 0;
        for (int l = 0; l < DEPTH; ++l) {
            unsigned char* wl = ws + (size_t)l * WL_BYTES;
            for (int f = 0; f < 2; ++f) {
                const float* wg = (f ? P.ffn2_wg : P.ffn1_wg) + (size_t)l * DM * DFF; const float* wu = (f ? P.ffn2_wu : P.ffn1_wu) + (size_t)l * DM * DFF;
                const float* wd = (f ? P.ffn2_wd : P.ffn1_wd) + (size_t)l * DFF * DM;
                conv_items([=](int n) -> const float* { const int t = n >> 8, w = n & 255; return (w < 128) ? wg + 128 * t + w : wu + 128 * t + (w - 128); },
                           DM, 2 * DFF, DFF, nullptr, (bf16_t*)(wl + (f ? WO_GU2 : WO_GU1)), scr, gw, NGW, lane, base);
                conv_items([=](int n) -> const float* { return wd + n; }, DFF, DM, DM, nullptr, (bf16_t*)(wl + (f ? WO_D2 : WO_D1)), scr, gw, NGW, lane, base);
            }
            { const float* w = P.w_in + (size_t)l * DM * 1216;
              conv_items([=](int n) -> const float* { if (n < 1152) return w + n; if (n < 1216) return w + 1152 + rope_dim(n - 1152); return nullptr; },
                         DM, NINP, 1216, nullptr, (bf16_t*)(wl + WO_IN), scr, gw, NGW, lane, base); }
            { const float* w = P.w_q_b + (size_t)l * QLORA * 768;
              conv_items([=](int n) -> const float* { const int hd = n / DQK, wi = n - hd * DQK; return (wi < DNOPE) ? w + n : w + hd * DQK + DNOPE + rope_dim(wi - DNOPE); },
                         QLORA, 768, 768, P.q_a_norm + (size_t)l * QLORA, (bf16_t*)(wl + WO_Q), scr, gw, NGW, lane, base); }
            { const float* w = P.w_kv_b + (size_t)l * KVLORA * 1024;
              conv_items([=](int n) -> const float* { return w + (n >> 7) * 256 + (n & 127); }, KVLORA, 512, 1024, P.kv_a_norm + (size_t)l * KVLORA, (bf16_t*)(wl + WO_K), scr, gw, NGW, lane, base);
              conv_items([=](int n) -> const float* { return w + (n >> 7) * 256 + 128 + (n & 127); }, KVLORA, 512, 1024, P.kv_a_norm + (size_t)l * KVLORA, (bf16_t*)(wl + WO_V), scr, gw, NGW, lane, base); }
            { const float* w = P.w_out + (size_t)l * DM * DM;
              conv_items([=](int n) -> const float* { return w + n; }, DM, DM, DM, nullptr, (bf16_t*)(wl + WO_O), scr, gw, NGW, lane, base); }
            { const float* pw = P.pool_w + (size_t)l * 4 * 128 * 128; bf16_t* WT = (bf16_t*)(wl + WO_P);
              for (int i = blockIdx.x * NTHREADS + tid; i < 512 * 512 / 2; i += G * NTHREADS) { const int n = i >> 8, k = (i & 255) * 2;
                  float v0 = 0.f, v1 = 0.f; if ((k >> 7) == (n >> 7)) { const float* s = pw + (size_t)(n >> 7) * 16384 + (n & 127); v0 = s[(k & 127) * 128]; v1 = s[((k + 1) & 127) * 128]; }
                  ((unsigned*)WT)[i] = cvtpk(v0, v1); } }
        }
    }
}

#undef P
__device__ __forceinline__ void norm_phase(const float* xin, const float* w, const float* sh, const float* sc, bf16_t* hn, const int tid_l) {
    const int lane = tid_l & 63, wave = tid_l >> 6, gw = blockIdx.x * NWAVES + wave, NGW = gridDim.x * NWAVES;
    f32x4 wv[4];
#pragma unroll
    for (int j = 0; j < 4; ++j) wv[j] = *(const f32x4*)(w + 4 * lane + 256 * j);
    for (int row = gw; row < TT; row += NGW) {
        const int b = row / SEQ; const f32x4* xr = (const f32x4*)(xin + (size_t)row * DM) + lane;
        f32x4 v[4]; float s = 0.f;
#pragma unroll
        for (int j = 0; j < 4; ++j) { v[j] = xr[64 * j]; s += (v[j][0] * v[j][0] + v[j][1] * v[j][1]) + (v[j][2] * v[j][2] + v[j][3] * v[j][3]); }
        const float r = 1.0f / sqrtf(wave_sum(s) * (1.0f / DM) + EPS);
#pragma unroll
        for (int j = 0; j < 4; ++j) { const f32x4 scv = *(const f32x4*)(sc + (size_t)b * MODW + 4 * lane + 256 * j), shv = *(const f32x4*)(sh + (size_t)b * MODW + 4 * lane + 256 * j);
            const f32x4 o = v[j] * r * wv[j] * (scv + 1.0f) + shv;
            u32x2 pk; pk.x = cvtpk(o[0], o[1]); pk.y = cvtpk(o[2], o[3]);
            *(u32x2*)(hn + (size_t)row * DM + 4 * lane + 256 * j) = pk; }
    }
}
__device__ __forceinline__ void final_norm_phase(float* x, const float* w, const int tid_l) {
    const int lane = tid_l & 63, wave = tid_l >> 6, gw = blockIdx.x * NWAVES + wave, NGW = gridDim.x * NWAVES;
    f32x4 wv[4];
#pragma unroll
    for (int j = 0; j < 4; ++j) wv[j] = *(const f32x4*)(w + 4 * lane + 256 * j);
    for (int row = gw; row < TT; row += NGW) {
        f32x4* xr = (f32x4*)(x + (size_t)row * DM) + lane;
        f32x4 v[4]; float s = 0.f;
#pragma unroll
        for (int j = 0; j < 4; ++j) { v[j] = xr[64 * j]; s += (v[j][0] * v[j][0] + v[j][1] * v[j][1]) + (v[j][2] * v[j][2] + v[j][3] * v[j][3]); }
        const float r = 1.0f / sqrtf(wave_sum(s) * (1.0f / DM) + EPS);
#pragma unroll
        for (int j = 0; j < 4; ++j) xr[64 * j] = v[j] * r * wv[j];
    }
}
__device__ __forceinline__ void pooldiff_phase(const bf16_t* z, bf16_t* diff, const int tid_l) {
    for (int i = blockIdx.x * NTHREADS + tid_l; i < TT * 64; i += gridDim.x * NTHREADS) {
        const int t = i >> 6, c8 = (i & 63) * 8, grp = c8 >> 7, w = 2 << grp, s = t & (SEQ - 1);
        const int cnt = (s + 1 < w) ? s + 1 : w;
        float a[8];
#pragma unroll
        for (int e = 0; e < 8; ++e) a[e] = 0.f;
        u32x4 cur = *(const u32x4*)(z + (size_t)t * NINP + c8);
        for (int j = 0; j < cnt; ++j) { const u32x4 v = *(const u32x4*)(z + (size_t)(t - j) * NINP + c8);
#pragma unroll
            for (int e = 0; e < 4; ++e) { a[2 * e] += __builtin_bit_cast(float, v[e] << 16); a[2 * e + 1] += __builtin_bit_cast(float, v[e] & 0xffff0000u); } }
        const float inv = 1.0f / (float)cnt;
        u32x4 o;
#pragma unroll
        for (int e = 0; e < 4; ++e) { const float u0 = __builtin_bit_cast(float, cur[e] << 16), u1 = __builtin_bit_cast(float, cur[e] & 0xffff0000u);
            o[e] = cvtpk(a[2 * e] * inv - u0, a[2 * e + 1] * inv - u1); }
        *(u32x4*)(diff + (size_t)t * 512 + c8) = o;
    }
}

constexpr int PH_PER_LAYER = 11, N_PHASES = 1 + DEPTH * PH_PER_LAYER + 1;
typedef const __attribute__((address_space(4))) Params* KArgs;

__global__ void __launch_bounds__(NTHREADS, 2) fwd_kernel(Params Pbyval) {
    extern __shared__ __attribute__((aligned(16))) unsigned char lds_raw[];
    LAS unsigned char* lds = (LAS unsigned char*)lds_raw;
    cg::grid_group grid = cg::this_grid();
    KArgs pp0 = (KArgs)__builtin_amdgcn_kernarg_segment_ptr();
    const int ph_lo = pp0->ph_lo, ph_hi = pp0->ph_hi;
    const int wave_s = __builtin_amdgcn_readfirstlane(threadIdx.x >> 6);

    for (int ph = ph_lo; ph < ph_hi; ++ph) {
        KArgs pp = pp0; asm volatile("" : "+s"(pp));
        int wv_ = wave_s; asm volatile("" : "+s"(wv_)); int tid = (wv_ << 6) | lane_id_opaque();
        int G = gridDim.x, bx = blockIdx.x; asm volatile("" : "+s"(G), "+s"(bx));
        unsigned char* ws = pp->ws;
        if (ph == 0) { prologue(pp, lds, tid); }
        else if (ph == N_PHASES - 1) { final_norm_phase(pp->out, pp->final_norm, tid); }
        else {
#ifdef DBG_SP
            const int l = (ph - 1) / PH_PER_LAYER, sp = DBG_SP;
#else
            const int l = (ph - 1) / PH_PER_LAYER, sp = (ph - 1) % PH_PER_LAYER;
#endif
            const unsigned char* wl = ws + (size_t)l * WL_BYTES;
            const float* modl = (const float*)(ws + WS_MOD) + (size_t)l * NBATCH * MODW;
            pg8::StaticOrder S;
            switch (sp) {
            case 0: norm_phase((l == 0) ? pp->x : pp->out, pp->ffn1_norm + (size_t)l * DM, modl + 0 * DM, modl + 1 * DM, (bf16_t*)(ws + WS_HN), tid); break;
            case 1: { pg8::Gemm g{(const bf16_t*)(ws + WS_HN), (const bf16_t*)(wl + WO_GU1), TT, 2 * DFF, DM, DM, DM}; S.init(TT, 2 * DFF, G, bx); EpiSwiglu E{(bf16_t*)(ws + WS_ACT)};
                      pg8::gemm_phase<EpiSwiglu, true>(lds, g, S, E, tid); } break;
            case 2: { pg8::Gemm g{(const bf16_t*)(ws + WS_ACT), (const bf16_t*)(wl + WO_D1), TT, DM, DFF, DFF, DFF}; S.init(TT, DM, G, bx); EpiResid E{(l == 0) ? pp->x : pp->out, pp->out, modl + 2 * DM, 0.5f};
                      pg8::gemm_phase<EpiResid, false>(lds, g, S, E, tid); } break;
            case 3: norm_phase(pp->out, pp->mix_norm + (size_t)l * DM, modl + 3 * DM, modl + 4 * DM, (bf16_t*)(ws + WS_HN), tid); break;
            case 4: { pg8::Gemm g{(const bf16_t*)(ws + WS_HN), (const bf16_t*)(wl + WO_IN), TT, NINP, DM, DM, DM}; S.init(TT, NINP, G, bx);
                      EpiIn E{(bf16_t*)(ws + WS_Z), (float*)(ws + WS_SSQ), (float*)(ws + WS_SSKV), (bf16_t*)(ws + WS_KR), (const float*)(ws + WS_COS), (const float*)(ws + WS_SIN)};
                      pg8::gemm_phase<EpiIn, true>(lds, g, S, E, tid); } break;
            case 5: {
                const bf16_t* z = (const bf16_t*)(ws + WS_Z);
                LAS float* rst = (LAS float*)(lds + 131072);
                pg8::Unit u0;
#if !defined(DBG_SUB) || DBG_SUB==0
                pooldiff_phase(z, (bf16_t*)(ws + WS_DIFF), tid);
#endif
#if !defined(DBG_SUB) || DBG_SUB==1
                tid = (wv_ << 6) | lane_id_opaque();
                { pg8::Gemm g{z + 512, (const bf16_t*)(wl + WO_Q), TT, 768, QLORA, NINP, QLORA}; S.init(TT, 768, G, bx);
                  if (S.next(0, u0) && tid < 256) rst[tid] = row_rs12((const float*)(ws + WS_SSQ) + (size_t)(u0.pm * 256 + tid) * 12) * QSCALE;
                  __syncthreads();
                  EpiQ E{(bf16_t*)(ws + WS_Q), rst, (const float*)(ws + WS_COS), (const float*)(ws + WS_SIN)};
                  pg8::gemm_phase<EpiQ, false>(lds, g, S, E, tid); }
#endif
#if !defined(DBG_SUB) || DBG_SUB==2
                tid = (wv_ << 6) | lane_id_opaque();
                { pg8::Gemm g{z + 896, (const bf16_t*)(wl + WO_K), TT, 512, KVLORA, NINP, KVLORA}; S.init(TT, 512, G, (bx + 64) % G);
                  if (S.next(0, u0) && tid < 256) rst[tid] = row_rs8((const float*)(ws + WS_SSKV) + (size_t)(u0.pm * 256 + tid) * 8);
                  __syncthreads();
                  EpiK E{(bf16_t*)(ws + WS_KN), rst};
                  pg8::gemm_phase<EpiK, false>(lds, g, S, E, tid); }
#endif
#if !defined(DBG_SUB) || DBG_SUB==3
                tid = (wv_ << 6) | lane_id_opaque();
                { pg8::Gemm g{(const bf16_t*)(wl + WO_V), z + 896, 512, TT, KVLORA, KVLORA, NINP}; S.init(512, TT, G, (bx + 192) % G);
                  if (S.next(0, u0) && tid < 256) rst[tid] = row_rs8((const float*)(ws + WS_SSKV) + (size_t)(u0.pn * 256 + tid) * 8);
                  __syncthreads();
                  EpiVt E{(bf16_t*)(ws + WS_VT), rst};
                  pg8::gemm_phase<EpiVt, false>(lds, g, S, E, tid); }
#endif
            } break;
            case 6: {
#if !defined(DBG_SUB) || DBG_SUB==0
                for (int it = bx; it < 256; it += G) { const int bh = it >> 3, s = it & 7, b = bh >> 2, h = bh & 3;
                    attn_unit(lds, (const bf16_t*)(ws + WS_Q), (const bf16_t*)(ws + WS_KN), (const bf16_t*)(ws + WS_KR), (const bf16_t*)(ws + WS_VT), (bf16_t*)(ws + WS_Y), b, h, 15 - s, tid);
                    attn_unit(lds, (const bf16_t*)(ws + WS_Q), (const bf16_t*)(ws + WS_KN), (const bf16_t*)(ws + WS_KR), (const bf16_t*)(ws + WS_VT), (bf16_t*)(ws + WS_Y), b, h, s, tid); }
#endif
#if !defined(DBG_SUB) || DBG_SUB==1
                tid = (wv_ << 6) | lane_id_opaque();
                { pg8::Gemm g{(const bf16_t*)(ws + WS_DIFF), (const bf16_t*)(wl + WO_P), TT, 512, 512, 512, 512}; S.init(TT, 512, G, bx); EpiPool E{(bf16_t*)(ws + WS_Y), pp->pool_scale + (size_t)l * 512};
                  pg8::gemm_phase<EpiPool, false>(lds, g, S, E, tid); }
#endif
            } break;
            case 7: { pg8::Gemm g{(const bf16_t*)(ws + WS_Y), (const bf16_t*)(wl + WO_O), TT, DM, DM, DM, DM}; S.init(TT, DM, G, bx); EpiResid E{pp->out, pp->out, modl + 5 * DM, 1.0f};
                      pg8::gemm_phase<EpiResid, false>(lds, g, S, E, tid); } break;
            case 8: norm_phase(pp->out, pp->ffn2_norm + (size_t)l * DM, modl + 6 * DM, modl + 7 * DM, (bf16_t*)(ws + WS_HN), tid); break;
            case 9: { pg8::Gemm g{(const bf16_t*)(ws + WS_HN), (const bf16_t*)(wl + WO_GU2), TT, 2 * DFF, DM, DM, DM}; S.init(TT, 2 * DFF, G, bx); EpiSwiglu E{(bf16_t*)(ws + WS_ACT)};
                      pg8::gemm_phase<EpiSwiglu, true>(lds, g, S, E, tid); } break;
            case 10: { pg8::Gemm g{(const bf16_t*)(ws + WS_ACT), (const bf16_t*)(wl + WO_D2), TT, DM, DFF, DFF, DFF}; S.init(TT, DM, G, bx); EpiResid E{pp->out, pp->out, modl + 8 * DM, 0.5f};
                      pg8::gemm_phase<EpiResid, false>(lds, g, S, E, tid); } break;
            }
        }
        if (ph + 1 < ph_hi) grid.sync();
    }
}

extern "C" void kernel_launch(void* const* d_in, const int* in_sizes, int n_in, void* d_out, int out_size, void* d_ws, size_t ws_size, hipStream_t stream) {
    static int grid = 0;
    if (grid == 0) {
        if (n_in != 23 || out_size != TT * DM || ws_size < WS_END) { fprintf(stderr, "kernel_launch: unexpected problem (n_in %d, out %d, ws %zu)\n", n_in, out_size, ws_size); grid = -1; return; }
        int dev = 0, cus = 0, per_cu = 0;
        hipGetDevice(&dev); hipDeviceGetAttribute(&cus, hipDeviceAttributeMultiprocessorCount, dev);
        hipFuncSetAttribute((const void*)fwd_kernel, hipFuncAttributeMaxDynamicSharedMemorySize, LDS_BYTES);
        hipOccupancyMaxActiveBlocksPerMultiprocessor(&per_cu, (const void*)fwd_kernel, NTHREADS, LDS_BYTES);
        (void)hipGetLastError();
        if (per_cu < 1) { fprintf(stderr, "kernel_launch: occupancy query says %d blocks per CU\n", per_cu); per_cu = 1; }
        grid = cus;
    }
    if (grid < 0) return;
    Params p{};
    p.x = (const float*)d_in[0]; p.c = (const float*)d_in[1]; p.pos = (const int*)d_in[2]; p.ada_w = (const float*)d_in[3]; p.ada_b = (const float*)d_in[4];
    p.ffn1_norm = (const float*)d_in[5]; p.ffn1_wg = (const float*)d_in[6]; p.ffn1_wu = (const float*)d_in[7]; p.ffn1_wd = (const float*)d_in[8];
    p.mix_norm = (const float*)d_in[9]; p.w_in = (const float*)d_in[10]; p.pool_w = (const float*)d_in[11]; p.pool_scale = (const float*)d_in[12];
    p.q_a_norm = (const float*)d_in[13]; p.w_q_b = (const float*)d_in[14]; p.kv_a_norm = (const float*)d_in[15]; p.w_kv_b = (const float*)d_in[16]; p.w_out = (const float*)d_in[17];
    p.ffn2_norm = (const float*)d_in[18]; p.ffn2_wg = (const float*)d_in[19]; p.ffn2_wu = (const float*)d_in[20]; p.ffn2_wd = (const float*)d_in[21]; p.final_norm = (const float*)d_in[22];
    p.out = (float*)d_out; p.ws = (unsigned char*)d_ws;
#if MK_ONE_LAUNCH
    p.ph_lo = 0; p.ph_hi = N_PHASES;
    void* args[] = {&p};
    hipError_t e = hipLaunchCooperativeKernel((const void*)fwd_kernel, dim3(grid), dim3(NTHREADS), args, LDS_BYTES, stream);
    if (e != hipSuccess) fprintf(stderr, "cooperative launch failed: %s (grid %d)\n", hipGetErrorString(e), grid);
#else
    for (int ph = 0; ph < N_PHASES; ++ph) { p.ph_lo = ph; p.ph_hi = ph + 1;
        hipLaunchKernelGGL(fwd_kernel, dim3(grid), dim3(NTHREADS), LDS_BYTES, stream, p); }
#endif
}
```

```cpp
#include <hip/hip_runtime.h>
#include <hip/hip_cooperative_groups.h>
#include <cstdio>
#include <cstdint>
namespace cg = cooperative_groups;

#ifndef MK_ONE_LAUNCH
#define MK_ONE_LAUNCH 1
#endif

#define LAS __attribute__((address_space(3)))
typedef unsigned short bf16_t;
typedef short bf16x8 __attribute__((ext_vector_type(8)));
typedef float f32x4 __attribute__((ext_vector_type(4)));
typedef float f32x2 __attribute__((ext_vector_type(2)));
typedef float f32x16 __attribute__((ext_vector_type(16)));
typedef unsigned u32x4 __attribute__((ext_vector_type(4)));
typedef unsigned u32x2 __attribute__((ext_vector_type(2)));
typedef __bf16 bf16x2_t __attribute__((ext_vector_type(2)));

constexpr int DM = 1024, NBATCH = 8, SEQ = 2048, TT = NBATCH * SEQ, DEPTH = 4, DFF = 2816;
constexpr int NINP = 1280;
constexpr int QLORA = 384, KVLORA = 256, NHEAD = 4, DQK = 192, DNOPE = 128, DROPE = 64, DVH = 128;
constexpr int MODW = 9 * DM;
constexpr float EPS = 1e-6f;
constexpr float QSCALE = 0.07216878364870322f * 1.4426950408889634f;

constexpr size_t MiB = 1u << 20;
constexpr size_t WL_BYTES = 40 * MiB;
constexpr size_t WO_GU1 = 0, WO_D1 = 11534336, WO_GU2 = 17301504, WO_D2 = 28835840, WO_IN = 34603008, WO_Q = 37224448, WO_K = 37814272,
                 WO_V = 38076416, WO_P = 38338560, WO_O = 38862848;
constexpr size_t WS_MOD = 160 * MiB, WS_COS = 162 * MiB, WS_SIN = 164 * MiB, WS_SSQ = 166 * MiB, WS_SSKV = 167 * MiB, WS_HN = 168 * MiB,
                 WS_ACT = 200 * MiB, WS_Z = 288 * MiB, WS_DIFF = 328 * MiB, WS_Q = 344 * MiB, WS_KN = 368 * MiB, WS_KR = 384 * MiB,
                 WS_VT = 386 * MiB, WS_Y = 402 * MiB, WS_CTL = 434 * MiB, WS_END = 435 * MiB;
constexpr size_t CTL_BYTES = 16384;
constexpr int LDS_BARST = 147456 - 64;

constexpr int NWAVES = 8, NTHREADS = 512;
constexpr int LDS_BYTES = 147456;

__device__ __forceinline__ unsigned cvtpk(float lo, float hi) { f32x2 v = {lo, hi}; bf16x2_t b = __builtin_convertvector(v, bf16x2_t); return __builtin_bit_cast(unsigned, b); }
__device__ __forceinline__ float bf2f(unsigned short h) { return __builtin_bit_cast(float, (unsigned)h << 16); }
__device__ __forceinline__ float wave_sum(float v) {
#pragma unroll
    for (int o = 1; o < 64; o <<= 1) v += __shfl_xor(v, o);
    return v;
}
__device__ __forceinline__ int lane_id_opaque() { int l; asm volatile("v_mbcnt_lo_u32_b32 %0, -1, 0\n\tv_mbcnt_hi_u32_b32 %0, -1, %0" : "=v"(l)); return l; }
__device__ __forceinline__ float silu_f(float x) { return x / (1.0f + __expf(-x)); }

namespace pg8 {
constexpr int BM = 256, BK = 64, HALF = 128, HTB = HALF * BK * 2, STAGE_BYTES = 8 * HTB, NXCD = 8, WGM = 8;
__host__ __device__ __forceinline__ int lds_byte(int r, int c) { const int st = (r >> 4) * 2 + (c >> 5), rr = r & 15, cc = c & 31, ob = rr * 64 + cc * 2; return st * 1024 + (ob ^ (((ob >> 9) & 1) << 5)); }
__host__ __device__ __forceinline__ void stage_rc(int b, int& R, int& C) { const int st = b / 1024, sb = b % 1024, swz = sb ^ (((sb >> 9) & 1) << 5); R = (st >> 1) * 16 + swz / 64; C = (st & 1) * 32 + (swz % 64) / 2; }
__host__ __device__ __forceinline__ int perm32(int rho) { const int n = rho >> 4, i = rho & 15; return 8 * (i >> 2) + 4 * n + (i & 3); }

struct Unit { int pm, pn; };
struct Gemm { const bf16_t* A; const bf16_t* Bt; int M, N, K, lda, ldb; };

struct StaticOrder {
    int nM, nN, nwg, G, c;
    __host__ __device__ void init(int M, int N, int G_, int c_) { nM = M / BM; nN = N / BM; nwg = nM * nN; G = G_; c = c_; }
    __host__ __device__ bool next(int i, Unit& u) const {
        const long L = (long)i * G + c; if (L >= nwg) return false;
        int wgid = (int)L; { const int q = nwg / NXCD, r = nwg % NXCD, xcd = wgid % NXCD, off = wgid / NXCD; wgid = (xcd < r ? xcd * (q + 1) : r * (q + 1) + (xcd - r) * q) + off; }
        const int nig = WGM * nN, gid = wgid / nig, fm = gid * WGM, gsz = (nM - fm) < WGM ? (nM - fm) : WGM;
        u.pm = fm + ((wgid % nig) % gsz); u.pn = (wgid % nig) / gsz; return true;
    }
};

template <class Epi, bool ALIGN_EPI>
__device__ __forceinline__ void gemm_phase(LAS unsigned char* lds, const Gemm g, const StaticOrder& S, const Epi& E, const int tid_l) {
    const int tid = tid_l, wid = __builtin_amdgcn_readfirstlane(tid >> 6), lane = tid & 63, wr = wid >> 2, wc = wid & 3, fr = lane & 15, fq = lane >> 4;
    const int K = g.K, nt = K / BK;
    unsigned voffA[2], voffB[2];
#pragma unroll
    for (int i = 0; i < 2; ++i) { int R, C; stage_rc(tid * 16 + i * 8192, R, C); const int Rb = Epi::PERM ? ((R & ~31) + perm32(R & 31)) : R;
        voffA[i] = (unsigned)(R * g.lda + C) * 2u; voffB[i] = (unsigned)(Rb * g.ldb + C) * 2u; }
    const size_t kstep = (size_t)(BK * 2);
    const size_t hstepA = (size_t)HALF * g.lda * 2, hstepB = (size_t)HALF * g.ldb * 2;
    const size_t tstepA = 2 * hstepA, tstepB = 2 * hstepB;
    const unsigned ldsw = (unsigned)wid * 1024u;
    const int aoff = lds_byte(wr * 64 + fr, fq * 8), boff = lds_byte(wc * 32 + fr, fq * 8);
#define PG8_SA(b, h) (((b) * 2 + (h)) * HTB)
#define PG8_SB(b, h) ((4 + (b) * 2 + (h)) * HTB)
#define PG8_STAGE(bufoff, gbase, voff) do { _Pragma("unroll") for (int _i = 0; _i < 2; ++_i) \
        __builtin_amdgcn_global_load_lds((const unsigned*)((const char*)(gbase) + (voff)[_i]), (LAS unsigned*)(lds + (bufoff) + ldsw + _i * 8192), 16, 0, 0); } while (0)
#define PG8_LDA(dst, b, h) do { _Pragma("unroll") for (int m = 0; m < 4; ++m) _Pragma("unroll") for (int k = 0; k < 2; ++k) dst[m][k] = *(const LAS bf16x8*)(lds + PG8_SA(b, h) + aoff + m * 2048 + k * 1024); } while (0)
#define PG8_LDB(dst, b, h) do { _Pragma("unroll") for (int n = 0; n < 2; ++n) _Pragma("unroll") for (int k = 0; k < 2; ++k) dst[n][k] = *(const LAS bf16x8*)(lds + PG8_SB(b, h) + boff + n * 2048 + k * 1024); } while (0)
#define PG8_MMA(ai, bj, At, Bt) do { __builtin_amdgcn_s_setprio(1); _Pragma("unroll") for (int m = 0; m < 4; ++m) _Pragma("unroll") for (int n = 0; n < 2; ++n) _Pragma("unroll") for (int k = 0; k < 2; ++k) \
        acc[ai][bj][m][n] = __builtin_amdgcn_mfma_f32_16x16x32_bf16(Bt[n][k], At[m][k], acc[ai][bj][m][n], 0, 0, 0); __builtin_amdgcn_s_setprio(0); } while (0)
#define PG8_WAIT_V(n) asm volatile("s_waitcnt vmcnt(" #n ")" ::: "memory")
#define PG8_WAIT_L(n) asm volatile("s_waitcnt lgkmcnt(" #n ")" ::: "memory")
#define PG8_BAR __builtin_amdgcn_s_barrier()
#define PG8_SCHED __builtin_amdgcn_sched_barrier(0)
    Unit cur, nxt; int ui = 0;
    if (!S.next(0, cur)) return;
    f32x4 acc[2][2][4][2];
#pragma unroll
    for (int a = 0; a < 2; ++a)
#pragma unroll
        for (int b = 0; b < 2; ++b)
#pragma unroll
            for (int m = 0; m < 4; ++m)
#pragma unroll
                for (int n = 0; n < 2; ++n) acc[a][b][m][n] = (f32x4){0.f, 0.f, 0.f, 0.f};
    bf16x8 At[4][2], B0[2][2], B1[2][2];
    const char* cA = (const char*)g.A + (size_t)cur.pm * tstepA; const char* cB = (const char*)g.Bt + (size_t)cur.pn * tstepB;
    PG8_STAGE(PG8_SB(0, 0), cB, voffB); PG8_STAGE(PG8_SB(0, 1), cB + hstepB, voffB); PG8_STAGE(PG8_SA(0, 0), cA, voffA); PG8_STAGE(PG8_SA(0, 1), cA + hstepA, voffA);
    if (wr == 1) PG8_BAR;
    PG8_WAIT_V(2); PG8_BAR;
    PG8_STAGE(PG8_SB(1, 0), cB + kstep, voffB); PG8_STAGE(PG8_SA(1, 0), cA + kstep, voffA); PG8_STAGE(PG8_SB(1, 1), cB + hstepB + kstep, voffB);
    PG8_WAIT_V(6); PG8_BAR;
    for (;;) {
        const bool has_next = S.next(ui + 1, nxt);
        const char* nA = has_next ? (const char*)g.A + (size_t)nxt.pm * tstepA : cA; const char* nB = has_next ? (const char*)g.Bt + (size_t)nxt.pn * tstepB : cB;
        for (int t = 0; t < nt; t += 2) {
            const bool last = (t == nt - 2);
            const char* a1 = cA + (size_t)(t + 1) * kstep;
            const char* a2 = last ? nA : cA + (size_t)(t + 2) * kstep; const char* b2 = last ? nB : cB + (size_t)(t + 2) * kstep;
            const char* a3 = a2 + kstep; const char* b3 = b2 + kstep;
            PG8_LDB(B0, 0, 0); PG8_LDB(B1, 0, 1); PG8_SCHED; PG8_LDA(At, 0, 0); PG8_STAGE(PG8_SA(1, 1), a1 + hstepA, voffA);
            PG8_WAIT_V(8); PG8_WAIT_L(0); PG8_BAR; PG8_MMA(0, 0, At, B0); PG8_MMA(0, 1, At, B1); PG8_BAR; PG8_SCHED;
            PG8_LDA(At, 0, 1); PG8_STAGE(PG8_SB(0, 0), b2, voffB); PG8_STAGE(PG8_SB(0, 1), b2 + hstepB, voffB); PG8_STAGE(PG8_SA(0, 0), a2, voffA);
            PG8_WAIT_V(8); PG8_WAIT_L(0); PG8_BAR; PG8_MMA(1, 0, At, B0); PG8_MMA(1, 1, At, B1); PG8_BAR; PG8_SCHED;
            PG8_LDB(B0, 1, 0); PG8_LDB(B1, 1, 1); PG8_SCHED; PG8_LDA(At, 1, 0); PG8_STAGE(PG8_SA(0, 1), a2 + hstepA, voffA);
            PG8_WAIT_V(8); PG8_WAIT_L(0); PG8_BAR; PG8_MMA(0, 0, At, B0); PG8_MMA(0, 1, At, B1); PG8_BAR; PG8_SCHED;
            PG8_LDA(At, 1, 1); PG8_STAGE(PG8_SB(1, 0), b3, voffB); PG8_STAGE(PG8_SB(1, 1), b3 + hstepB, voffB); PG8_STAGE(PG8_SA(1, 0), a3, voffA);
            PG8_WAIT_V(8); PG8_WAIT_L(0); PG8_BAR; PG8_MMA(1, 0, At, B0); PG8_MMA(1, 1, At, B1); PG8_BAR; PG8_SCHED;
        }
        if constexpr (ALIGN_EPI) { if (wr == 0) PG8_BAR; }
        { const int le = lane_id_opaque(); E(acc, cur, wr, wc, le & 15, le >> 4); }
        if (!has_next) break;
#pragma unroll
        for (int a = 0; a < 2; ++a)
#pragma unroll
            for (int b = 0; b < 2; ++b)
#pragma unroll
                for (int m = 0; m < 4; ++m)
#pragma unroll
                    for (int n = 0; n < 2; ++n) acc[a][b][m][n] = (f32x4){0.f, 0.f, 0.f, 0.f};
        cur = nxt; cA = nA; cB = nB; ++ui;
        if constexpr (ALIGN_EPI) { if (wr == 1) PG8_BAR; }
    }
    PG8_WAIT_V(0);
    if constexpr (!ALIGN_EPI) { if (wr == 0) PG8_BAR; }
    PG8_BAR;
#undef PG8_SA
#undef PG8_SB
#undef PG8_STAGE
#undef PG8_LDA
#undef PG8_LDB
#undef PG8_MMA
#undef PG8_WAIT_V
#undef PG8_WAIT_L
#undef PG8_BAR
#undef PG8_SCHED
}
}

typedef f32x4 Acc[2][2][4][2];

struct EpiSwiglu {
    static constexpr bool PERM = true;
    bf16_t* act;
    __device__ __forceinline__ void operator()(const Acc& acc, const pg8::Unit& u, int wr, int wc, int fr, int fq) const {
        const int row0 = u.pm * 256 + wr * 64 + fr, col = u.pn * 128 + wc * 32 + 8 * fq;
#pragma unroll
        for (int ai = 0; ai < 2; ++ai)
#pragma unroll
            for (int m = 0; m < 4; ++m) {
                const f32x4 g0 = acc[ai][0][m][0], g1 = acc[ai][0][m][1], u0 = acc[ai][1][m][0], u1 = acc[ai][1][m][1];
                float a[8];
#pragma unroll
                for (int j = 0; j < 4; ++j) { a[j] = silu_f(g0[j]) * u0[j]; a[4 + j] = silu_f(g1[j]) * u1[j]; }
                u32x4 w; w.x = cvtpk(a[0], a[1]); w.y = cvtpk(a[2], a[3]); w.z = cvtpk(a[4], a[5]); w.w = cvtpk(a[6], a[7]);
                *(u32x4*)(act + (size_t)(row0 + ai * 128 + m * 16) * DFF + col) = w;
            }
    }
};
struct EpiResid {
    static constexpr bool PERM = false;
    const float* base; float* out; const float* gate; float coef;
    __device__ __forceinline__ void operator()(const Acc& acc, const pg8::Unit& u, int wr, int wc, int fr, int fq) const {
        const int row0 = u.pm * 256 + wr * 64 + fr, col0 = u.pn * 256 + wc * 32 + 4 * fq;
        const int b = (u.pm * 256) / SEQ;
        f32x4 gv[2][2];
#pragma unroll
        for (int bj = 0; bj < 2; ++bj)
#pragma unroll
            for (int n = 0; n < 2; ++n) gv[bj][n] = *(const f32x4*)(gate + (size_t)b * MODW + col0 + bj * 128 + n * 16) * coef;
#pragma unroll
        for (int ai = 0; ai < 2; ++ai)
#pragma unroll
            for (int m = 0; m < 4; ++m) { const size_t off = (size_t)(row0 + ai * 128 + m * 16) * DM + col0;
#pragma unroll
                for (int bj = 0; bj < 2; ++bj)
#pragma unroll
                    for (int n = 0; n < 2; ++n) { const f32x4 bs = *(const f32x4*)(base + off + bj * 128 + n * 16);
                        *(f32x4*)(out + off + bj * 128 + n * 16) = bs + gv[bj][n] * acc[ai][bj][m][n]; }
                if (m & 1) asm volatile("" ::: "memory"); }
    }
};
struct EpiIn {
    static constexpr bool PERM = true;
    bf16_t* z; float* ssq; float* sskv; bf16_t* kr; const float* cosT; const float* sinT;
    __device__ __forceinline__ void operator()(const Acc& acc, const pg8::Unit& u, int wr, int wc, int fr, int fq) const {
        const int row0 = u.pm * 256 + wr * 64 + fr;
#pragma unroll
        for (int bj = 0; bj < 2; ++bj) {
            const int cg0 = u.pn * 256 + bj * 128 + wc * 32;
            if (cg0 >= 1216) continue;
            if (cg0 >= 1152) {
                const int i0 = ((cg0 - 1152) >> 5) * 16 + 4 * fq;
#pragma unroll
                for (int ai = 0; ai < 2; ++ai)
#pragma unroll
                    for (int m = 0; m < 4; ++m) { const int row = row0 + ai * 128 + m * 16;
                        const f32x4 c = *(const f32x4*)(cosT + (size_t)row * 32 + i0), s = *(const f32x4*)(sinT + (size_t)row * 32 + i0);
                        const f32x4 x1 = acc[ai][bj][m][0], x2 = acc[ai][bj][m][1];
                        const f32x4 o1 = x1 * c - x2 * s, o2 = x2 * c + x1 * s;
                        u32x2 w1, w2; w1.x = cvtpk(o1[0], o1[1]); w1.y = cvtpk(o1[2], o1[3]); w2.x = cvtpk(o2[0], o2[1]); w2.y = cvtpk(o2[2], o2[3]);
                        *(u32x2*)(kr + (size_t)row * DROPE + i0) = w1; *(u32x2*)(kr + (size_t)row * DROPE + 32 + i0) = w2; }
                continue;
            }
            float* ssp = nullptr; int slot = 0, nsl = 0;
            if (cg0 >= 896) { ssp = sskv; slot = (cg0 - 896) >> 5; nsl = 8; } else if (cg0 >= 512) { ssp = ssq; slot = (cg0 - 512) >> 5; nsl = 12; }
#pragma unroll
            for (int ai = 0; ai < 2; ++ai)
#pragma unroll
                for (int m = 0; m < 4; ++m) { const int row = row0 + ai * 128 + m * 16;
                    const f32x4 v0 = acc[ai][bj][m][0], v1 = acc[ai][bj][m][1];
                    u32x4 w; w.x = cvtpk(v0[0], v0[1]); w.y = cvtpk(v0[2], v0[3]); w.z = cvtpk(v1[0], v1[1]); w.w = cvtpk(v1[2], v1[3]);
                    *(u32x4*)(z + (size_t)row * NINP + cg0 + 8 * fq) = w;
                    if (ssp) { float q = (v0[0] * v0[0] + v0[1] * v0[1]) + (v0[2] * v0[2] + v0[3] * v0[3]) + (v1[0] * v1[0] + v1[1] * v1[1]) + (v1[2] * v1[2] + v1[3] * v1[3]);
                        q += __shfl_xor(q, 16); q += __shfl_xor(q, 32);
                        if (fq == 0) ssp[(size_t)row * nsl + slot] = q; } }
        }
    }
};
__device__ __forceinline__ float row_rs12(const float* p) { const f32x4 a = *(const f32x4*)p, b = *(const f32x4*)(p + 4), c = *(const f32x4*)(p + 8);
    const float s = ((a[0] + a[1]) + (a[2] + a[3])) + ((b[0] + b[1]) + (b[2] + b[3])) + ((c[0] + c[1]) + (c[2] + c[3])); return __builtin_amdgcn_rsqf(s * (1.0f / QLORA) + EPS); }
__device__ __forceinline__ float row_rs8(const float* p) { const f32x4 a = *(const f32x4*)p, b = *(const f32x4*)(p + 4);
    const float s = ((a[0] + a[1]) + (a[2] + a[3])) + ((b[0] + b[1]) + (b[2] + b[3])); return __builtin_amdgcn_rsqf(s * (1.0f / KVLORA) + EPS); }
struct EpiQ {
    static constexpr bool PERM = true;
    bf16_t* q; const LAS float* rst; const float* cosT; const float* sinT;
    __device__ __forceinline__ void operator()(const Acc& acc, const pg8::Unit& u, int wr, int wc, int fr, int fq) const {
        const int row0 = u.pm * 256 + wr * 64 + fr;
#pragma unroll
        for (int ai = 0; ai < 2; ++ai)
#pragma unroll
            for (int m = 0; m < 4; ++m) { const int row = row0 + ai * 128 + m * 16;
                const float rs = rst[ai * 128 + wr * 64 + m * 16 + fr];
#pragma unroll
                for (int bj = 0; bj < 2; ++bj) {
                    const int cg0 = u.pn * 256 + bj * 128 + wc * 32, head = cg0 / DQK, within = cg0 - head * DQK;
                    const f32x4 x1 = acc[ai][bj][m][0] * rs, x2 = acc[ai][bj][m][1] * rs;
                    if (within < DNOPE) { u32x4 w; w.x = cvtpk(x1[0], x1[1]); w.y = cvtpk(x1[2], x1[3]); w.z = cvtpk(x2[0], x2[1]); w.w = cvtpk(x2[2], x2[3]);
                        *(u32x4*)(q + (size_t)row * 768 + cg0 + 8 * fq) = w; }
                    else { const int i0 = ((within - DNOPE) >> 5) * 16 + 4 * fq;
                        const f32x4 c = *(const f32x4*)(cosT + (size_t)row * 32 + i0), s = *(const f32x4*)(sinT + (size_t)row * 32 + i0);
                        const f32x4 o1 = x1 * c - x2 * s, o2 = x2 * c + x1 * s;
                        u32x2 w1, w2; w1.x = cvtpk(o1[0], o1[1]); w1.y = cvtpk(o1[2], o1[3]); w2.x = cvtpk(o2[0], o2[1]); w2.y = cvtpk(o2[2], o2[3]);
                        bf16_t* qp = q + (size_t)row * 768 + head * DQK + DNOPE + i0;
                        *(u32x2*)qp = w1; *(u32x2*)(qp + 32) = w2; } }
                asm volatile("" ::: "memory"); }
    }
};
struct EpiK {
    static constexpr bool PERM = true;
    bf16_t* kn; const LAS float* rst;
    __device__ __forceinline__ void operator()(const Acc& acc, const pg8::Unit& u, int wr, int wc, int fr, int fq) const {
        const int row0 = u.pm * 256 + wr * 64 + fr, col0 = u.pn * 256 + wc * 32 + 8 * fq;
#pragma unroll
        for (int ai = 0; ai < 2; ++ai)
#pragma unroll
            for (int m = 0; m < 4; ++m) { const int row = row0 + ai * 128 + m * 16;
                const float rs = rst[ai * 128 + wr * 64 + m * 16 + fr];
#pragma unroll
                for (int bj = 0; bj < 2; ++bj) { const f32x4 x1 = acc[ai][bj][m][0] * rs, x2 = acc[ai][bj][m][1] * rs;
                    u32x4 w; w.x = cvtpk(x1[0], x1[1]); w.y = cvtpk(x1[2], x1[3]); w.z = cvtpk(x2[0], x2[1]); w.w = cvtpk(x2[2], x2[3]);
                    *(u32x4*)(kn + (size_t)row * 512 + col0 + bj * 128) = w; }
                asm volatile("" ::: "memory"); }
    }
};
struct EpiVt {
    static constexpr bool PERM = true;
    bf16_t* vt; const LAS float* rst;
    __device__ __forceinline__ void operator()(const Acc& acc, const pg8::Unit& u, int wr, int wc, int fr, int fq) const {
        const int row0 = u.pm * 256 + wr * 64 + fr;
        const int t0 = u.pn * 256 + wc * 32 + 8 * fq;
        const int b = (u.pn * 256) / SEQ, s0 = t0 - b * SEQ;
#pragma unroll
        for (int bj = 0; bj < 2; ++bj) {
            const f32x4 ra = *(const LAS f32x4*)(rst + bj * 128 + wc * 32 + 8 * fq), rb = *(const LAS f32x4*)(rst + bj * 128 + wc * 32 + 8 * fq + 4);
            const float rs[8] = {ra[0], ra[1], ra[2], ra[3], rb[0], rb[1], rb[2], rb[3]};
#pragma unroll
            for (int ai = 0; ai < 2; ++ai)
#pragma unroll
                for (int m = 0; m < 4; ++m) { const int r = row0 + ai * 128 + m * 16;
                    const f32x4 x1 = acc[ai][bj][m][0], x2 = acc[ai][bj][m][1];
                    u32x4 w; w.x = cvtpk(x1[0] * rs[0], x1[1] * rs[1]); w.y = cvtpk(x1[2] * rs[2], x1[3] * rs[3]); w.z = cvtpk(x2[0] * rs[4], x2[1] * rs[5]); w.w = cvtpk(x2[2] * rs[6], x2[3] * rs[7]);
                    *(u32x4*)(vt + ((size_t)b * 512 + r) * SEQ + s0 + bj * 128) = w; }
        }
    }
};
struct EpiPool {
    static constexpr bool PERM = true;
    bf16_t* y; const float* ps;
    __device__ __forceinline__ void operator()(const Acc& acc, const pg8::Unit& u, int wr, int wc, int fr, int fq) const {
        const int row0 = u.pm * 256 + wr * 64 + fr, col0 = u.pn * 256 + wc * 32 + 8 * fq;
#pragma unroll
        for (int bj = 0; bj < 2; ++bj) { const f32x4 p0 = *(const f32x4*)(ps + col0 + bj * 128), p1 = *(const f32x4*)(ps + col0 + bj * 128 + 4);
#pragma unroll
            for (int ai = 0; ai < 2; ++ai)
#pragma unroll
                for (int m = 0; m < 4; ++m) { const int row = row0 + ai * 128 + m * 16;
                    const f32x4 x1 = acc[ai][bj][m][0] * p0, x2 = acc[ai][bj][m][1] * p1;
                    u32x4 w; w.x = cvtpk(x1[0], x1[1]); w.y = cvtpk(x1[2], x1[3]); w.z = cvtpk(x2[0], x2[1]); w.w = cvtpk(x2[2], x2[3]);
                    *(u32x4*)(y + (size_t)row * DM + col0 + bj * 128) = w; } }
    }
};

constexpr int AK_ROWB = 400, AK_TILEB = 64 * AK_ROWB;
constexpr int AV_ROWB = 144, AV_TILEB = 128 * AV_ROWB;
constexpr int ALDS_K = 0, ALDS_V = 2 * AK_TILEB, ALDS_Q = ALDS_V + 2 * AV_TILEB;
__device__ __forceinline__ int crow(int r, int hi) { return (r & 3) + 8 * (r >> 2) + 4 * hi; }
#define MFMA32(a, b, c) __builtin_amdgcn_mfma_f32_32x32x16_bf16((a), (b), (c), 0, 0, 0)

__device__ __forceinline__ void attn_unit(LAS unsigned char* lds, const bf16_t* __restrict__ Q, const bf16_t* __restrict__ KN, const bf16_t* __restrict__ KR,
                                          const bf16_t* __restrict__ VT, bf16_t* __restrict__ Y, int b, int h, int u, const int tid_l) {
    const int tid = tid_l, lane = tid & 63, wid = __builtin_amdgcn_readfirstlane(tid >> 6), rg = wid & 3, g = wid >> 2, ql = lane & 31, hi = lane >> 5;
    const int q0 = 128 * u + 32 * rg;
    const size_t tb = (size_t)b * SEQ;
    const LAS unsigned char* qfl = lds + ALDS_Q + rg * (32 * AK_ROWB) + ql * AK_ROWB + hi * 16;
    if (g == 0) { const bf16_t* qp = Q + (tb + q0 + ql) * 768 + h * DQK + 8 * hi;
#pragma unroll
      for (int s = 0; s < 12; ++s) *(LAS bf16x8*)(lds + ALDS_Q + rg * (32 * AK_ROWB) + ql * AK_ROWB + hi * 16 + s * 32) = *(const bf16x8*)(qp + 16 * s); }
    f32x16 oT[4];
#pragma unroll
    for (int d = 0; d < 4; ++d)
#pragma unroll
        for (int r = 0; r < 16; ++r) oT[d][r] = 0.f;
    float mrun = -1e30f, lrun = 0.f;
    const int nsteps = u + 1;
    const bf16_t* knp = KN + (tb + (tid >> 4)) * 512 + h * 128 + 8 * (tid & 15);
    const bf16_t* krp = KR + (tb + (tid >> 3)) * DROPE + 8 * (tid & 7);
    const bf16_t* vtp = VT + ((size_t)((b * 4 + h) * 128 + (tid >> 3))) * SEQ + 8 * (tid & 7);
    const unsigned kndst = ALDS_K + (tid >> 4) * AK_ROWB + (tid & 15) * 16, krdst = ALDS_K + (tid >> 3) * AK_ROWB + 256 + (tid & 7) * 16, vdst = ALDS_V + (tid >> 3) * AV_ROWB + (tid & 7) * 16;
    u32x4 kreg[6], vreg[4];
#define A_LOAD(j) do { _Pragma("unroll") for (int i = 0; i < 4; ++i) kreg[i] = *(const u32x4*)(knp + ((size_t)(j) * 128 + 64 * (i >> 1) + 32 * (i & 1)) * 512); \
                       _Pragma("unroll") for (int i = 0; i < 2; ++i) kreg[4 + i] = *(const u32x4*)(krp + ((size_t)(j) * 128 + 64 * i) * DROPE); \
                       _Pragma("unroll") for (int i = 0; i < 4; ++i) vreg[i] = *(const u32x4*)(vtp + (size_t)(64 * (i & 1)) * SEQ + (j) * 128 + 64 * (i >> 1)); } while (0)
#define A_STORE() do { _Pragma("unroll") for (int i = 0; i < 4; ++i) *(LAS u32x4*)(lds + kndst + (i >> 1) * AK_TILEB + 32 * (i & 1) * AK_ROWB) = kreg[i]; \
                       _Pragma("unroll") for (int i = 0; i < 2; ++i) *(LAS u32x4*)(lds + krdst + i * AK_TILEB) = kreg[4 + i]; \
                       _Pragma("unroll") for (int i = 0; i < 4; ++i) *(LAS u32x4*)(lds + vdst + (i >> 1) * AV_TILEB + 64 * (i & 1) * AV_ROWB) = vreg[i]; } while (0)
    A_LOAD(0); A_STORE(); __syncthreads();
    const LAS unsigned char* kt = lds + ALDS_K + g * AK_TILEB + ql * AK_ROWB + hi * 16;
    const LAS unsigned char* vtl = lds + ALDS_V + g * AV_TILEB + ql * AV_ROWB + hi * 8;
    for (int j = 0; j < nsteps; ++j) {
        if (j + 1 < nsteps) A_LOAD(j + 1);
        const int key0 = 64 * (2 * j + g);
        if (key0 <= q0 + 31) {
            f32x16 s0, s1;
#pragma unroll
            for (int r = 0; r < 16; ++r) { s0[r] = 0.f; s1[r] = 0.f; }
#pragma unroll
            for (int s = 0; s < 12; ++s) { const bf16x8 a0 = *(const LAS bf16x8*)(kt + s * 32), a1 = *(const LAS bf16x8*)(kt + 32 * AK_ROWB + s * 32), qv = *(const LAS bf16x8*)(qfl + s * 32);
                s0 = MFMA32(a0, qv, s0); s1 = MFMA32(a1, qv, s1); }
            if (key0 + 63 > q0) { const int qpos = q0 + ql;
#pragma unroll
                for (int r = 0; r < 16; ++r) { const int kk = key0 + crow(r, hi); if (kk > qpos) s0[r] = -INFINITY; if (kk + 32 > qpos) s1[r] = -INFINITY; } }
            float mx = fmaxf(s0[0], s1[0]);
#pragma unroll
            for (int r = 1; r < 16; ++r) mx = fmaxf(mx, fmaxf(s0[r], s1[r]));
            mx = fmaxf(mx, __shfl_xor(mx, 32));
            const float mn = fmaxf(mrun, mx), alpha = __builtin_amdgcn_exp2f(mrun - mn); mrun = mn;
            float ls = 0.f;
#pragma unroll
            for (int r = 0; r < 16; ++r) { s0[r] = __builtin_amdgcn_exp2f(s0[r] - mn); s1[r] = __builtin_amdgcn_exp2f(s1[r] - mn); ls += s0[r] + s1[r]; }
            lrun = lrun * alpha + ls;
#pragma unroll
            for (int d = 0; d < 4; ++d)
#pragma unroll
                for (int r = 0; r < 16; ++r) oT[d][r] *= alpha;
            bf16x8 pb[2][2];
#pragma unroll
            for (int sp = 0; sp < 2; ++sp) { u32x4 w0, w1;
                w0.x = cvtpk(s0[8 * sp + 0], s0[8 * sp + 1]); w0.y = cvtpk(s0[8 * sp + 2], s0[8 * sp + 3]); w0.z = cvtpk(s0[8 * sp + 4], s0[8 * sp + 5]); w0.w = cvtpk(s0[8 * sp + 6], s0[8 * sp + 7]);
                w1.x = cvtpk(s1[8 * sp + 0], s1[8 * sp + 1]); w1.y = cvtpk(s1[8 * sp + 2], s1[8 * sp + 3]); w1.z = cvtpk(s1[8 * sp + 4], s1[8 * sp + 5]); w1.w = cvtpk(s1[8 * sp + 6], s1[8 * sp + 7]);
                pb[0][sp] = __builtin_bit_cast(bf16x8, w0); pb[1][sp] = __builtin_bit_cast(bf16x8, w1); }
#pragma unroll
            for (int d = 0; d < 4; ++d)
#pragma unroll
                for (int kb = 0; kb < 2; ++kb)
#pragma unroll
                    for (int sp = 0; sp < 2; ++sp) { const LAS unsigned char* vp = vtl + d * 32 * AV_ROWB + (32 * kb + 16 * sp) * 2;
                        const u32x2 lo = *(const LAS u32x2*)vp, hh = *(const LAS u32x2*)(vp + 16);
                        u32x4 a; a.x = lo.x; a.y = lo.y; a.z = hh.x; a.w = hh.y;
                        oT[d] = MFMA32(__builtin_bit_cast(bf16x8, a), pb[kb][sp], oT[d]); }
        }
        __syncthreads();
        if (j + 1 < nsteps) A_STORE();
        __syncthreads();
    }
#undef A_LOAD
#undef A_STORE
    LAS float* mo = (LAS float*)lds;
    LAS float* ml = (LAS float*)(lds + 65536);
    if (g == 1) {
#pragma unroll
        for (int d = 0; d < 4; ++d)
#pragma unroll
            for (int r = 0; r < 16; ++r) mo[(rg * 64 + d * 16 + r) * 64 + lane] = oT[d][r];
        ml[(rg * 2 + 0) * 64 + lane] = mrun; ml[(rg * 2 + 1) * 64 + lane] = lrun;
    }
    __syncthreads();
    if (g == 0) {
        const float m1 = ml[(rg * 2 + 0) * 64 + lane], l1 = ml[(rg * 2 + 1) * 64 + lane];
        const float mn = fmaxf(mrun, m1), f0 = __builtin_amdgcn_exp2f(mrun - mn), f1 = __builtin_amdgcn_exp2f(m1 - mn);
        float lt = lrun * f0 + l1 * f1; lt += __shfl_xor(lt, 32);
        const float inv = 1.0f / lt, c0 = f0 * inv, c1 = f1 * inv;
        bf16_t* yp = Y + (tb + q0 + ql) * DM + 512 + h * DVH + 4 * hi;
#pragma unroll
        for (int d = 0; d < 4; ++d)
#pragma unroll
            for (int r4 = 0; r4 < 4; ++r4) { float o[4];
#pragma unroll
                for (int e = 0; e < 4; ++e) { const int r = 4 * r4 + e; o[e] = oT[d][r] * c0 + mo[(rg * 64 + d * 16 + r) * 64 + lane] * c1; }
                u32x2 w; w.x = cvtpk(o[0], o[1]); w.y = cvtpk(o[2], o[3]);
                *(u32x2*)(yp + 32 * d + 8 * r4) = w; }
    }
    __syncthreads();
}


#define XB_TMO      128
#define XB_XCNT(j)  (256  + 64 * (j))
#define XB_XSUB(j)  (1280 + 64 * (j))
#define XB_XGEN(j)  (2304 + 64 * (j))
#define XB_TOP      3328
#define XB_TOPGEN   3392
#define XCD_BAR_WORDS 3456
#define XB_SPIN_CAP (1u << 22)
__device__ __forceinline__ unsigned xb_ld(unsigned* p)              { return __hip_atomic_load(p, __ATOMIC_RELAXED, __HIP_MEMORY_SCOPE_AGENT); }
__device__ __forceinline__ unsigned xb_add(unsigned* p, unsigned v) { return __hip_atomic_fetch_add(p, v, __ATOMIC_RELAXED, __HIP_MEMORY_SCOPE_AGENT); }
__device__ __forceinline__ unsigned xb_xcc_id() { return (unsigned)__builtin_amdgcn_s_getreg((3 << 11) | 20) & 0xFu; }
#define XB_SPIN(cond, bar) do { unsigned _sp = 0; while (cond) { __builtin_amdgcn_s_sleep(1); \
    if ((++_sp & 255u) == 0u) { if (xb_ld(&(bar)[XB_TMO])) break; if (_sp > XB_SPIN_CAP) { atomicAdd(&(bar)[XB_TMO], 1u); break; } } } } while (0)
__device__ __forceinline__ void xcd_barrier_complete(unsigned* bar, unsigned x, unsigned& nloc, unsigned& nx) {
    const unsigned G = gridDim.x * gridDim.y * gridDim.z;
    unsigned sum, cnt, mine, sp = 0u;
    for (;;) {
        sum = 0u; cnt = 0u; mine = 0u;
#pragma unroll
        for (unsigned j = 0; j < 16; ++j) { const unsigned c = xb_ld(&bar[XB_XCNT(j)]); sum += c; cnt += (c > 0u) ? 1u : 0u; mine = (j == x) ? c : mine; }
        if (sum == G) break;
        __builtin_amdgcn_s_sleep(1);
        if ((++sp & 255u) == 0u) { if (xb_ld(&bar[XB_TMO])) break; if (sp > XB_SPIN_CAP) { atomicAdd(&bar[XB_TMO], 1u); break; } }
    }
    nloc = mine > 0u ? mine : 1u; nx = cnt > 0u ? cnt : 1u;
}
__device__ __forceinline__ void xcd_barrier(unsigned* bar, volatile LAS unsigned* st, bool leader) {
    asm volatile("s_waitcnt vmcnt(0)" ::: "memory");
    __syncthreads();
    if (leader) {
        const unsigned x = xb_xcc_id();
        __builtin_amdgcn_s_waitcnt(0);
        unsigned nloc = st[0], nx = st[1];
        if (nloc == 0u) { xcd_barrier_complete(bar, x, nloc, nx); st[0] = nloc; st[1] = nx; }
        const unsigned old = xb_add(&bar[XB_XSUB(x)], 1u);
        const unsigned gen = old / nloc;
        if (old + 1u == (gen + 1u) * nloc) {
            __builtin_amdgcn_fence(__ATOMIC_RELEASE, "agent");
            asm volatile("s_waitcnt vmcnt(0)" ::: "memory");
            const unsigned og = xb_add(&bar[XB_TOP], 1u);
            const unsigned tg = og / nx;
            if (og + 1u == (tg + 1u) * nx) xb_add(&bar[XB_TOPGEN], 1u);
            else XB_SPIN(xb_ld(&bar[XB_TOPGEN]) == tg, bar);
            __builtin_amdgcn_fence(__ATOMIC_ACQUIRE, "agent");
            xb_add(&bar[XB_XGEN(x)], 1u);
            asm volatile("s_waitcnt vmcnt(0)" ::: "memory");
        } else {
            XB_SPIN(xb_ld(&bar[XB_XGEN(x)]) == gen, bar);
            __builtin_amdgcn_fence(__ATOMIC_ACQUIRE, "agent");
            asm volatile("s_waitcnt vmcnt(0)" ::: "memory");
        }
    }
    __syncthreads();
}

struct Params {
    const float* x; const float* c; const int* pos; const float* ada_w; const float* ada_b;
    const float* ffn1_norm; const float* ffn1_wg; const float* ffn1_wu; const float* ffn1_wd;
    const float* mix_norm; const float* w_in; const float* pool_w; const float* pool_scale;
    const float* q_a_norm; const float* w_q_b; const float* kv_a_norm; const float* w_kv_b; const float* w_out;
    const float* ffn2_norm; const float* ffn2_wg; const float* ffn2_wu; const float* ffn2_wd; const float* final_norm;
    float* out; unsigned char* ws; int ph_lo, ph_hi;
};

struct ColMap { const float* p; };
template <class MapF>
__device__ __forceinline__ void conv_items(MapF mapf, int K, int Nout, int ldw, const float* gain, bf16_t* WT, LAS float* scr, int gw, int NGW, int lane, int& base) {
    const int nblk = Nout / 32, nitems = (K / 64) * nblk;
    int start = (gw - (base % NGW) + NGW) % NGW;
    for (int it = start; it < nitems; it += NGW) {
        const int kb = it / nblk, nb = it - kb * nblk, k0 = 64 * kb, n0 = 32 * nb;
        const float* src = mapf(n0 + (lane & 31));
#pragma unroll 8
        for (int i = 0; i < 32; ++i) { const int kk = 2 * i + (lane >> 5); float v = src ? src[(size_t)(k0 + kk) * ldw] : 0.f; if (gain) v *= gain[k0 + kk]; scr[kk * 33 + (lane & 31)] = v; }
        asm volatile("s_waitcnt lgkmcnt(0)" ::: "memory");
        const int c = lane & 7;
#pragma unroll
        for (int j = 0; j < 4; ++j) { const int n = (lane >> 3) + 8 * j; const LAS float* s = scr + (8 * c) * 33 + n;
            u32x4 o; o.x = cvtpk(s[0 * 33], s[1 * 33]); o.y = cvtpk(s[2 * 33], s[3 * 33]); o.z = cvtpk(s[4 * 33], s[5 * 33]); o.w = cvtpk(s[6 * 33], s[7 * 33]);
            *(u32x4*)(WT + (size_t)(n0 + n) * K + k0 + 8 * c) = o; }
        asm volatile("s_waitcnt lgkmcnt(0)" ::: "memory");
    }
    base += nitems;
}
__device__ __forceinline__ int rope_dim(int p) { const int g = p >> 5, rho = p & 31; return 16 * g + 4 * (rho >> 3) + (rho & 3) + 32 * ((rho >> 2) & 1); }

typedef const __attribute__((address_space(4))) struct Params* KArgsP;
__device__ __forceinline__ void prologue(KArgsP PP, LAS unsigned char* lds, const int tid_l) {
#define P (*PP)
    const int tid = tid_l, lane = tid & 63, wave = __builtin_amdgcn_readfirstlane(tid >> 6);
    const int G = gridDim.x, gw = blockIdx.x * NWAVES + wave, NGW = G * NWAVES;
    unsigned char* ws = P.ws;
    {
        LAS float* ca = (LAS float*)lds;
        LAS float* red = (LAS float*)(lds + 32768);
        for (int i = tid; i < NBATCH * DM; i += NTHREADS) ca[i] = silu_f(P.c[i]);
        __syncthreads();
        float* mod = (float*)(ws + WS_MOD);
        for (int it = blockIdx.x; it < DEPTH * (MODW / 64); it += G) {
            const int l = it / (MODW / 64), n0 = (it - l * (MODW / 64)) * 64;
            const float* W = P.ada_w + (size_t)l * DM * MODW + n0 + lane;
            float a[8];
#pragma unroll
            for (int b = 0; b < 8; ++b) a[b] = 0.f;
            const int kb0 = wave * 128;
#pragma unroll 8
            for (int k = 0; k < 128; ++k) { const float w = W[(size_t)(kb0 + k) * MODW];
#pragma unroll
                for (int b = 0; b < 8; ++b) a[b] += ca[b * DM + kb0 + k] * w; }
#pragma unroll
            for (int b = 0; b < 8; ++b) red[(wave * 8 + b) * 64 + lane] = a[b];
            __syncthreads();
            { float s = 0.f;
#pragma unroll
              for (int w = 0; w < 8; ++w) s += red[(w * 8 + wave) * 64 + lane];
              mod[((size_t)l * NBATCH + wave) * MODW + n0 + lane] = s + P.ada_b[(size_t)l * MODW + n0 + lane]; }
            __syncthreads();
        }
    }
    {
        float* cosT = (float*)(ws + WS_COS); float* sinT = (float*)(ws + WS_SIN);
        for (int i = blockIdx.x * NTHREADS + tid; i < TT * 32; i += G * NTHREADS) {
            const int t = i >> 5, d = i & 31;
            const float invf = 1.0f / powf(10000.0f, (float)(2 * d) * (1.0f / 64.0f));
            const float ang = (float)P.pos[t] * invf;
            const double rev = (double)ang * 0.15915494309189535; const float fr = (float)(rev - floor(rev));
            cosT[i] = __builtin_amdgcn_cosf(fr); sinT[i] = __builtin_amdgcn_sinf(fr);
        }
    }
    {
        LAS float* scr = (LAS float*)(lds + 65536 + wave * 8704);
        int base = 0;
        for (int l = 0; l < DEPTH; ++l) {
            unsigned char* wl = ws + (size_t)l * WL_BYTES;
            for (int f = 0; f < 2; ++f) {
                const float* wg = (f ? P.ffn2_wg : P.ffn1_wg) + (size_t)l * DM * DFF; const float* wu = (f ? P.ffn2_wu : P.ffn1_wu) + (size_t)l * DM * DFF;
                const float* wd = (f ? P.ffn2_wd : P.ffn1_wd) + (size_t)l * DFF * DM;
                conv_items([=](int n) -> const float* { const int t = n >> 8, w = n & 255; return (w < 128) ? wg + 128 * t + w : wu + 128 * t + (w - 128); },
                           DM, 2 * DFF, DFF, nullptr, (bf16_t*)(wl + (f ? WO_GU2 : WO_GU1)), scr, gw, NGW, lane, base);
                conv_items([=](int n) -> const float* { return wd + n; }, DFF, DM, DM, nullptr, (bf16_t*)(wl + (f ? WO_D2 : WO_D1)), scr, gw, NGW, lane, base);
            }
            { const float* w = P.w_in + (size_t)l * DM * 1216;
              conv_items([=](int n) -> const float* { if (n < 1152) return w + n; if (n < 1216) return w + 1152 + rope_dim(n - 1152); return nullptr; },
                         DM, NINP, 1216, nullptr, (bf16_t*)(wl + WO_IN), scr, gw, NGW, lane, base); }
            { const float* w = P.w_q_b + (size_t)l * QLORA * 768;
              conv_items([=](int n) -> const float* { const int hd = n / DQK, wi = n - hd * DQK; return (wi < DNOPE) ? w + n : w + hd * DQK + DNOPE + rope_dim(wi - DNOPE); },
                         QLORA, 768, 768, P.q_a_norm + (size_t)l * QLORA, (bf16_t*)(wl + WO_Q), scr, gw, NGW, lane, base); }
            { const float* w = P.w_kv_b + (size_t)l * KVLORA * 1024;
              conv_items([=](int n) -> const float* { return w + (n >> 7) * 256 + (n & 127); }, KVLORA, 512, 1024, P.kv_a_norm + (size_t)l * KVLORA, (bf16_t*)(wl + WO_K), scr, gw, NGW, lane, base);
              conv_items([=](int n) -> const float* { return w + (n >> 7) * 256 + 128 + (n & 127); }, KVLORA, 512, 1024, P.kv_a_norm + (size_t)l * KVLORA, (bf16_t*)(wl + WO_V), scr, gw, NGW, lane, base); }
            { const float* w = P.w_out + (size_t)l * DM * DM;
              conv_items([=](int n) -> const float* { return w + n; }, DM, DM, DM, nullptr, (bf16_t*)(wl + WO_O), scr, gw, NGW, lane, base); }
            { const float* pw = P.pool_w + (size_t)l * 4 * 128 * 128; bf16_t* WT = (bf16_t*)(wl + WO_P);
              for (int i = blockIdx.x * NTHREADS + tid; i < 512 * 512 / 2; i += G * NTHREADS) { const int n = i >> 8, k = (i & 255) * 2;
                  float v0 = 0.f, v1 = 0.f; if ((k >> 7) == (n >> 7)) { const float* s = pw + (size_t)(n >> 7) * 16384 + (n & 127); v0 = s[(k & 127) * 128]; v1 = s[((k + 1) & 127) * 128]; }
                  ((unsigned*)WT)[i] = cvtpk(v0, v1); } }
        }
    }
}

#undef P
__device__ __forceinline__ void norm_phase(const float* xin, const float* w, const float* sh, const float* sc, bf16_t* hn, const int tid_l) {
    const int lane = tid_l & 63, wave = tid_l >> 6, gw = blockIdx.x * NWAVES + wave, NGW = gridDim.x * NWAVES;
    f32x4 wv[4];
#pragma unroll
    for (int j = 0; j < 4; ++j) wv[j] = *(const f32x4*)(w + 4 * lane + 256 * j);
    for (int row = gw; row < TT; row += NGW) {
        const int b = row / SEQ; const f32x4* xr = (const f32x4*)(xin + (size_t)row * DM) + lane;
        f32x4 v[4]; float s = 0.f;
#pragma unroll
        for (int j = 0; j < 4; ++j) { v[j] = xr[64 * j]; s += (v[j][0] * v[j][0] + v[j][1] * v[j][1]) + (v[j][2] * v[j][2] + v[j][3] * v[j][3]); }
        const float r = 1.0f / sqrtf(wave_sum(s) * (1.0f / DM) + EPS);
#pragma unroll
        for (int j = 0; j < 4; ++j) { const f32x4 scv = *(const f32x4*)(sc + (size_t)b * MODW + 4 * lane + 256 * j), shv = *(const f32x4*)(sh + (size_t)b * MODW + 4 * lane + 256 * j);
            const f32x4 o = v[j] * r * wv[j] * (scv + 1.0f) + shv;
            u32x2 pk; pk.x = cvtpk(o[0], o[1]); pk.y = cvtpk(o[2], o[3]);
            *(u32x2*)(hn + (size_t)row * DM + 4 * lane + 256 * j) = pk; }
    }
}
__device__ __forceinline__ void final_norm_phase(float* x, const float* w, const int tid_l) {
    const int lane = tid_l & 63, wave = tid_l >> 6, gw = blockIdx.x * NWAVES + wave, NGW = gridDim.x * NWAVES;
    f32x4 wv[4];
#pragma unroll
    for (int j = 0; j < 4; ++j) wv[j] = *(const f32x4*)(w + 4 * lane + 256 * j);
    for (int row = gw; row < TT; row += NGW) {
        f32x4* xr = (f32x4*)(x + (size_t)row * DM) + lane;
        f32x4 v[4]; float s = 0.f;
#pragma unroll
        for (int j = 0; j < 4; ++j) { v[j] = xr[64 * j]; s += (v[j][0] * v[j][0] + v[j][1] * v[j][1]) + (v[j][2] * v[j][2] + v[j][3] * v[j][3]); }
        const float r = 1.0f / sqrtf(wave_sum(s) * (1.0f / DM) + EPS);
#pragma unroll
        for (int j = 0; j < 4; ++j) xr[64 * j] = v[j] * r * wv[j];
    }
}
__device__ __forceinline__ void pooldiff_phase(const bf16_t* z, bf16_t* diff, const int tid_l) {
    for (int i = blockIdx.x * NTHREADS + tid_l; i < TT * 64; i += gridDim.x * NTHREADS) {
        const int t = i >> 6, c8 = (i & 63) * 8, grp = c8 >> 7, w = 2 << grp, s = t & (SEQ - 1);
        const int cnt = (s + 1 < w) ? s + 1 : w;
        float a[8];
#pragma unroll
        for (int e = 0; e < 8; ++e) a[e] = 0.f;
        u32x4 cur = *(const u32x4*)(z + (size_t)t * NINP + c8);
        for (int j = 0; j < cnt; ++j) { const u32x4 v = *(const u32x4*)(z + (size_t)(t - j) * NINP + c8);
#pragma unroll
            for (int e = 0; e < 4; ++e) { a[2 * e] += __builtin_bit_cast(float, v[e] << 16); a[2 * e + 1] += __builtin_bit_cast(float, v[e] & 0xffff0000u); } }
        const float inv = 1.0f / (float)cnt;
        u32x4 o;
#pragma unroll
        for (int e = 0; e < 4; ++e) { const float u0 = __builtin_bit_cast(float, cur[e] << 16), u1 = __builtin_bit_cast(float, cur[e] & 0xffff0000u);
            o[e] = cvtpk(a[2 * e] * inv - u0, a[2 * e + 1] * inv - u1); }
        *(u32x4*)(diff + (size_t)t * 512 + c8) = o;
    }
}

constexpr int PH_PER_LAYER = 11, N_PHASES = 1 + DEPTH * PH_PER_LAYER + 1;
typedef const __attribute__((address_space(4))) Params* KArgs;

__global__ void __launch_bounds__(NTHREADS, 2) fwd_kernel(Params Pbyval) {
    extern __shared__ __attribute__((aligned(16))) unsigned char lds_raw[];
    LAS unsigned char* lds = (LAS unsigned char*)lds_raw;
    cg::grid_group grid = cg::this_grid();
    KArgs pp0 = (KArgs)__builtin_amdgcn_kernarg_segment_ptr();
    const int ph_lo = pp0->ph_lo, ph_hi = pp0->ph_hi;
    const int wave_s = __builtin_amdgcn_readfirstlane(threadIdx.x >> 6);
    volatile LAS unsigned* barst = (volatile LAS unsigned*)(lds + LDS_BARST);
    if (threadIdx.x == 0) { barst[0] = 0u; barst[1] = 0u; (void)xb_add((unsigned*)(pp0->ws + WS_CTL) + XB_XCNT(xb_xcc_id()), 1u); }
    __syncthreads();

    for (int ph = ph_lo; ph < ph_hi; ++ph) {
        KArgs pp = pp0; asm volatile("" : "+s"(pp));
        int wv_ = wave_s; asm volatile("" : "+s"(wv_));
#define TIDN ((wv_ << 6) | lane_id_opaque())
        int G = gridDim.x, bx = blockIdx.x; asm volatile("" : "+s"(G), "+s"(bx));
        unsigned char* ws = pp->ws;
#ifdef PROBE_MASK
        int nrep_ = 1;
        if (ph == 0) { if (PROBE_MASK & (1 << 11)) nrep_ = 2; } else if (ph < N_PHASES - 1) { if (PROBE_MASK & (1 << ((ph - 1) % PH_PER_LAYER))) nrep_ = 2; }
        for (int rep_ = 0; rep_ < nrep_; ++rep_) {
        if (rep_) { __syncthreads(); grid.sync(); }
#endif
        if (ph == 0) { prologue(pp, lds, TIDN); }
        else if (ph == N_PHASES - 1) { final_norm_phase(pp->out, pp->final_norm, TIDN); }
        else {
#ifdef DBG_SP
            const int l = (ph - 1) / PH_PER_LAYER, sp = DBG_SP;
#else
            const int l = (ph - 1) / PH_PER_LAYER, sp = (ph - 1) % PH_PER_LAYER;
#endif
            const unsigned char* wl = ws + (size_t)l * WL_BYTES;
            const float* modl = (const float*)(ws + WS_MOD) + (size_t)l * NBATCH * MODW;
            pg8::StaticOrder S;
            switch (sp) {
            case 0: norm_phase((l == 0) ? pp->x : pp->out, pp->ffn1_norm + (size_t)l * DM, modl + 0 * DM, modl + 1 * DM, (bf16_t*)(ws + WS_HN), TIDN); break;
            case 1: { pg8::Gemm g{(const bf16_t*)(ws + WS_HN), (const bf16_t*)(wl + WO_GU1), TT, 2 * DFF, DM, DM, DM}; S.init(TT, 2 * DFF, G, bx); EpiSwiglu E{(bf16_t*)(ws + WS_ACT)};
                      pg8::gemm_phase<EpiSwiglu, true>(lds, g, S, E, TIDN); } break;
            case 2: { pg8::Gemm g{(const bf16_t*)(ws + WS_ACT), (const bf16_t*)(wl + WO_D1), TT, DM, DFF, DFF, DFF}; S.init(TT, DM, G, bx); EpiResid E{(l == 0) ? pp->x : pp->out, pp->out, modl + 2 * DM, 0.5f};
                      pg8::gemm_phase<EpiResid, false>(lds, g, S, E, TIDN); } break;
            case 3: norm_phase(pp->out, pp->mix_norm + (size_t)l * DM, modl + 3 * DM, modl + 4 * DM, (bf16_t*)(ws + WS_HN), TIDN); break;
            case 4: { pg8::Gemm g{(const bf16_t*)(ws + WS_HN), (const bf16_t*)(wl + WO_IN), TT, NINP, DM, DM, DM}; S.init(TT, NINP, G, bx);
                      EpiIn E{(bf16_t*)(ws + WS_Z), (float*)(ws + WS_SSQ), (float*)(ws + WS_SSKV), (bf16_t*)(ws + WS_KR), (const float*)(ws + WS_COS), (const float*)(ws + WS_SIN)};
                      pg8::gemm_phase<EpiIn, true>(lds, g, S, E, TIDN); } break;
            case 5: {
                const bf16_t* z = (const bf16_t*)(ws + WS_Z);
                LAS float* rst = (LAS float*)(lds + 131072);
                pg8::Unit u0;
#if !defined(DBG_SUB) || DBG_SUB==0
                pooldiff_phase(z, (bf16_t*)(ws + WS_DIFF), TIDN);
#endif
#if !defined(DBG_SUB) || DBG_SUB==1
                                { pg8::Gemm g{z + 512, (const bf16_t*)(wl + WO_Q), TT, 768, QLORA, NINP, QLORA}; S.init(TT, 768, G, bx);
                  { const int t_ = TIDN; if (S.next(0, u0) && t_ < 256) rst[t_] = row_rs12((const float*)(ws + WS_SSQ) + (size_t)(u0.pm * 256 + t_) * 12) * QSCALE; }
                  __syncthreads();
                  EpiQ E{(bf16_t*)(ws + WS_Q), rst, (const float*)(ws + WS_COS), (const float*)(ws + WS_SIN)};
                  pg8::gemm_phase<EpiQ, false>(lds, g, S, E, TIDN); }
#endif
#if !defined(DBG_SUB) || DBG_SUB==2
                                { pg8::Gemm g{z + 896, (const bf16_t*)(wl + WO_K), TT, 512, KVLORA, NINP, KVLORA}; S.init(TT, 512, G, (bx + 64) % G);
                  { const int t_ = TIDN; if (S.next(0, u0) && t_ < 256) rst[t_] = row_rs8((const float*)(ws + WS_SSKV) + (size_t)(u0.pm * 256 + t_) * 8); }
                  __syncthreads();
                  EpiK E{(bf16_t*)(ws + WS_KN), rst};
                  pg8::gemm_phase<EpiK, false>(lds, g, S, E, TIDN); }
#endif
#if !defined(DBG_SUB) || DBG_SUB==3
                                { pg8::Gemm g{(const bf16_t*)(wl + WO_V), z + 896, 512, TT, KVLORA, KVLORA, NINP}; S.init(512, TT, G, (bx + 192) % G);
                  { const int t_ = TIDN; if (S.next(0, u0) && t_ < 256) rst[t_] = row_rs8((const float*)(ws + WS_SSKV) + (size_t)(u0.pn * 256 + t_) * 8); }
                  __syncthreads();
                  EpiVt E{(bf16_t*)(ws + WS_VT), rst};
                  pg8::gemm_phase<EpiVt, false>(lds, g, S, E, TIDN); }
#endif
            } break;
            case 6: {
#if !defined(DBG_SUB) || DBG_SUB==0
                for (int it = bx; it < 256; it += G) { const int bh = it >> 3, s = it & 7, b = bh >> 2, h = bh & 3;
                    attn_unit(lds, (const bf16_t*)(ws + WS_Q), (const bf16_t*)(ws + WS_KN), (const bf16_t*)(ws + WS_KR), (const bf16_t*)(ws + WS_VT), (bf16_t*)(ws + WS_Y), b, h, 15 - s, TIDN);
                    attn_unit(lds, (const bf16_t*)(ws + WS_Q), (const bf16_t*)(ws + WS_KN), (const bf16_t*)(ws + WS_KR), (const bf16_t*)(ws + WS_VT), (bf16_t*)(ws + WS_Y), b, h, s, TIDN); }
#endif
#if !defined(DBG_SUB) || DBG_SUB==1
                                { pg8::Gemm g{(const bf16_t*)(ws + WS_DIFF), (const bf16_t*)(wl + WO_P), TT, 512, 512, 512, 512}; S.init(TT, 512, G, bx); EpiPool E{(bf16_t*)(ws + WS_Y), pp->pool_scale + (size_t)l * 512};
                  pg8::gemm_phase<EpiPool, false>(lds, g, S, E, TIDN); }
#endif
            } break;
            case 7: { pg8::Gemm g{(const bf16_t*)(ws + WS_Y), (const bf16_t*)(wl + WO_O), TT, DM, DM, DM, DM}; S.init(TT, DM, G, bx); EpiResid E{pp->out, pp->out, modl + 5 * DM, 1.0f};
                      pg8::gemm_phase<EpiResid, false>(lds, g, S, E, TIDN); } break;
            case 8: norm_phase(pp->out, pp->ffn2_norm + (size_t)l * DM, modl + 6 * DM, modl + 7 * DM, (bf16_t*)(ws + WS_HN), TIDN); break;
            case 9: { pg8::Gemm g{(const bf16_t*)(ws + WS_HN), (const bf16_t*)(wl + WO_GU2), TT, 2 * DFF, DM, DM, DM}; S.init(TT, 2 * DFF, G, bx); EpiSwiglu E{(bf16_t*)(ws + WS_ACT)};
                      pg8::gemm_phase<EpiSwiglu, true>(lds, g, S, E, TIDN); } break;
            case 10: { pg8::Gemm g{(const bf16_t*)(ws + WS_ACT), (const bf16_t*)(wl + WO_D2), TT, DM, DFF, DFF, DFF}; S.init(TT, DM, G, bx); EpiResid E{pp->out, pp->out, modl + 8 * DM, 0.5f};
                      pg8::gemm_phase<EpiResid, false>(lds, g, S, E, TIDN); } break;
            }
        }
#ifdef PROBE_MASK
        }
        if ((PROBE_MASK & (1 << 12)) && ph + 1 < ph_hi) grid.sync();
#endif
        if (ph + 1 < ph_hi) { if (ph == 0) grid.sync(); else xcd_barrier((unsigned*)(ws + WS_CTL), barst, (wv_ == 0) && (lane_id_opaque() == 0)); }
    }
}

extern "C" void kernel_launch(void* const* d_in, const int* in_sizes, int n_in, void* d_out, int out_size, void* d_ws, size_t ws_size, hipStream_t stream) {
    static int grid = 0;
    if (grid == 0) {
        if (n_in != 23 || out_size != TT * DM || ws_size < WS_END) { fprintf(stderr, "kernel_launch: unexpected problem (n_in %d, out %d, ws %zu)\n", n_in, out_size, ws_size); grid = -1; return; }
        int dev = 0, cus = 0, per_cu = 0;
        hipGetDevice(&dev); hipDeviceGetAttribute(&cus, hipDeviceAttributeMultiprocessorCount, dev);
        hipFuncSetAttribute((const void*)fwd_kernel, hipFuncAttributeMaxDynamicSharedMemorySize, LDS_BYTES);
        hipOccupancyMaxActiveBlocksPerMultiprocessor(&per_cu, (const void*)fwd_kernel, NTHREADS, LDS_BYTES);
        (void)hipGetLastError();
        if (per_cu < 1) { fprintf(stderr, "kernel_launch: occupancy query says %d blocks per CU\n", per_cu); per_cu = 1; }
        grid = cus;
    }
    if (grid < 0) return;
    Params p{};
    p.x = (const float*)d_in[0]; p.c = (const float*)d_in[1]; p.pos = (const int*)d_in[2]; p.ada_w = (const float*)d_in[3]; p.ada_b = (const float*)d_in[4];
    p.ffn1_norm = (const float*)d_in[5]; p.ffn1_wg = (const float*)d_in[6]; p.ffn1_wu = (const float*)d_in[7]; p.ffn1_wd = (const float*)d_in[8];
    p.mix_norm = (const float*)d_in[9]; p.w_in = (const float*)d_in[10]; p.pool_w = (const float*)d_in[11]; p.pool_scale = (const float*)d_in[12];
    p.q_a_norm = (const float*)d_in[13]; p.w_q_b = (const float*)d_in[14]; p.kv_a_norm = (const float*)d_in[15]; p.w_kv_b = (const float*)d_in[16]; p.w_out = (const float*)d_in[17];
    p.ffn2_norm = (const float*)d_in[18]; p.ffn2_wg = (const float*)d_in[19]; p.ffn2_wu = (const float*)d_in[20]; p.ffn2_wd = (const float*)d_in[21]; p.final_norm = (const float*)d_in[22];
    p.out = (float*)d_out; p.ws = (unsigned char*)d_ws;
#if MK_ONE_LAUNCH
    if (hipMemsetAsync((char*)d_ws + WS_CTL, 0, CTL_BYTES, stream) != hipSuccess) { fprintf(stderr, "kernel_launch: memset of the barrier words failed\n"); return; }
    p.ph_lo = 0; p.ph_hi = N_PHASES;
    void* args[] = {&p};
    hipError_t e = hipLaunchCooperativeKernel((const void*)fwd_kernel, dim3(grid), dim3(NTHREADS), args, LDS_BYTES, stream);
    if (e != hipSuccess) fprintf(stderr, "cooperative launch failed: %s (grid %d)\n", hipGetErrorString(e), grid);
#else
    for (int ph = 0; ph < N_PHASES; ++ph) { p.ph_lo = ph; p.ph_hi = ph + 1;
        hipLaunchKernelGGL(fwd_kernel, dim3(grid), dim3(NTHREADS), LDS_BYTES, stream, p); }
#endif
}
```
